# Optimizing an MI355X kernel written in HIP

```python
import math
import jax, jax.numpy as jnp
from jax import lax
import numpy as np

D_MODEL = 1024
BATCH = 1
SEQ = 16384
DEPTH = 1

DN_HEADS = 4
DN_HEAD_DIM = 128
DN_WIDTH = DN_HEADS * DN_HEAD_DIM
CONV_WIDTH = 4
DN_CHUNK = 64
DA_HEADS = 4
DA_HEAD_DIM = 64
DA_WIDTH = DA_HEADS * 2 * DA_HEAD_DIM
Q_BLOCK = 128
ROPE_THETA = 10000.0
N_EXPERTS = 32
TOP_K = 4
D_EXPERT = D_MODEL
SWIGLU_LIMIT = 7.0
SWIGLU_ALPHA = 1.702
MOE_BLOCK = 256
N_MODS = 6
IN_SIZES = (DN_WIDTH, DN_WIDTH, DN_WIDTH, DN_WIDTH, DN_HEADS, DN_HEADS,
            DA_WIDTH, DA_WIDTH, DA_WIDTH, D_MODEL, D_MODEL)
IN_OFFSETS = tuple(sum(IN_SIZES[:i + 1]) for i in range(len(IN_SIZES) - 1))
IN_COLS = sum(IN_SIZES)

kernel_name = 'hybrid_deltanet_diffattn_moe_deepnorm_adaln'


def _deepnorm_alpha():
    return (2.0 * DEPTH) ** 0.25


def _deepnorm_beta():
    return (8.0 * DEPTH) ** -0.25


def _layer_norm(x, g, b, eps=1e-5):
    xf = x.astype(jnp.float32)
    mu = jnp.mean(xf, -1, keepdims=True)
    var = jnp.mean(jnp.square(xf - mu), -1, keepdims=True)
    return ((xf - mu) * lax.rsqrt(var + eps) * g + b).astype(x.dtype)


def _rms_norm(x, w, eps=1e-5):
    xf = x.astype(jnp.float32)
    return (xf * lax.rsqrt(jnp.mean(xf * xf, -1, keepdims=True) + eps) * w).astype(x.dtype)


def _l2_normalize(x, eps=1e-6):
    xf = x.astype(jnp.float32)
    return (xf * lax.rsqrt(jnp.sum(xf * xf, -1, keepdims=True) + eps)).astype(x.dtype)


def _causal_depthwise_conv(x, w):
    k, ch = w.shape
    return lax.conv_general_dilated(x, w[:, None, :].astype(x.dtype), window_strides=(1,),
                                    padding=[(k - 1, 0)], dimension_numbers=('NWC', 'WIO', 'NWC'),
                                    feature_group_count=ch)


def _rope(x, positions):
    d = x.shape[-1]
    half = d // 2
    inv_freq = ROPE_THETA ** (-jnp.arange(half, dtype=jnp.float32) / half)
    ang = positions.astype(jnp.float32)[..., None] * inv_freq
    ang = ang.reshape(ang.shape[:2] + (1,) * (x.ndim - 3) + (half,))
    cos, sin = jnp.cos(ang), jnp.sin(ang)
    xf = x.astype(jnp.float32)
    x1, x2 = xf[..., :half], xf[..., half:]
    return jnp.concatenate([x1 * cos - x2 * sin, x2 * cos + x1 * sin], -1).astype(x.dtype)


def _gated_delta_rule(q, k, v, g, beta):
    out_dtype = v.dtype
    b, s, h, dk = q.shape
    dv = v.shape[-1]
    c = DN_CHUNK
    n = s // c

    def to_chunks(t):
        t = t.astype(jnp.float32).reshape((b, n, c, h) + t.shape[3:])
        return jnp.moveaxis(t, 3, 1)

    q, k, v, g, beta = (to_chunks(t) for t in (q, k, v, g, beta))
    cum_g = jnp.cumsum(g, axis=-1)
    idx = jnp.arange(c)
    strict = idx[:, None] > idx[None, :]
    incl = idx[:, None] >= idx[None, :]
    decay = jnp.exp(jnp.where(incl, cum_g[..., :, None] - cum_g[..., None, :], -jnp.inf))
    kk = jnp.einsum('bhnid,bhnjd->bhnij', k, k)
    a_mat = jnp.where(strict, beta[..., None] * decay * kk, 0.0)
    lower = jnp.eye(c, dtype=jnp.float32) + a_mat
    rhs = jnp.concatenate([beta[..., None] * v, (beta * jnp.exp(cum_g))[..., None] * k], -1)
    sol = lax.linalg.triangular_solve(lower, rhs, left_side=True, lower=True)
    u_base, w_mat = sol[..., :dv], sol[..., dv:]
    qk = jnp.einsum('bhnid,bhnjd->bhnij', q, k) * decay
    q_dec = q * jnp.exp(cum_g)[..., None]
    k_dec = k * jnp.exp(cum_g[..., -1:] - cum_g)[..., None]
    chunk_decay = jnp.exp(cum_g[..., -1])

    def step(state, inp):
        u_b, w_c, qk_c, qd_c, kd_c, cd_c = inp
        u = u_b - jnp.einsum('bhcd,bhde->bhce', w_c, state)
        o = jnp.einsum('bhcd,bhde->bhce', qd_c, state) + jnp.einsum('bhij,bhje->bhie', qk_c, u)
        state = state * cd_c[..., None, None] + jnp.einsum('bhcd,bhce->bhde', kd_c, u)
        return state, o

    xs = tuple(jnp.moveaxis(t, 2, 0) for t in (u_base, w_mat, qk, q_dec, k_dec, chunk_decay))
    state0 = jnp.zeros((b, h, dk, dv), jnp.float32)
    _, o = lax.scan(step, state0, xs)
    o = jnp.transpose(o, (1, 0, 3, 2, 4)).reshape(b, s, h, dv)
    return o.astype(out_dtype)


def _diff_attention(q, k, v, lam):
    b, s, h, _, d = q.shape
    nblk = s // Q_BLOCK
    scale = d ** -0.5
    kpos = jnp.arange(s)

    def one_block(i):
        start = i * Q_BLOCK
        qb = lax.dynamic_slice_in_dim(q, start, Q_BLOCK, axis=1)
        sc = jnp.einsum('bqhmd,bkhmd->bhmqk', qb, k, preferred_element_type=jnp.float32) * scale
        qpos = start + jnp.arange(Q_BLOCK)
        mask = kpos[None, :] <= qpos[:, None]
        p = jax.nn.softmax(jnp.where(mask, sc, -jnp.inf), axis=-1)
        a = p[:, :, 0] - lam * p[:, :, 1]
        return jnp.einsum('bhqk,bkhe->bqhe', a.astype(v.dtype), v)

    o = lax.map(one_block, jnp.arange(nblk))
    return jnp.moveaxis(o, 0, 1).reshape(b, s, h, 2 * d)


def _clamped_swiglu(gu):
    x_glu, x_lin = gu[..., ::2], gu[..., 1::2]
    x_glu = jnp.minimum(x_glu, SWIGLU_LIMIT)
    x_lin = jnp.clip(x_lin, -SWIGLU_LIMIT, SWIGLU_LIMIT)
    return x_glu * jax.nn.sigmoid(SWIGLU_ALPHA * x_glu) * (x_lin + 1.0)


def _moe(h, w_router, b_router, w_gate_up, b_gate_up, w_down, b_down):
    b, s, d = h.shape
    m = b * s
    hf = h.reshape(m, d)
    logits = (hf @ w_router + b_router).astype(jnp.float32)
    top_val, top_idx = lax.top_k(logits, TOP_K)
    top_w = jax.nn.softmax(top_val, axis=-1)
    n_assign = m * TOP_K
    expert_flat = top_idx.reshape(-1).astype(jnp.int32)
    token_flat = jnp.arange(n_assign, dtype=jnp.int32) // TOP_K
    weight_flat = top_w.reshape(-1)
    order = jnp.argsort(expert_flat)
    e_sorted = expert_flat[order]
    counts = jnp.bincount(expert_flat, length=N_EXPERTS).astype(jnp.int32)
    group_start = jnp.cumsum(counts) - counts
    padded = (counts + MOE_BLOCK - 1) // MOE_BLOCK * MOE_BLOCK
    padded_end = jnp.cumsum(padded)
    padded_start = padded_end - padded
    rank = jnp.arange(n_assign, dtype=jnp.int32) - group_start[e_sorted]
    dest = padded_start[e_sorted] + rank
    n_blocks = -(-n_assign // MOE_BLOCK) + N_EXPERTS
    n_rows = n_blocks * MOE_BLOCK
    row_token = jnp.full((n_rows,), m, jnp.int32).at[dest].set(token_flat[order])
    row_weight = jnp.zeros((n_rows,), jnp.float32).at[dest].set(weight_flat[order])
    block_start = jnp.arange(n_blocks, dtype=jnp.int32) * MOE_BLOCK
    block_expert = jnp.minimum(jnp.searchsorted(padded_end, block_start, side='right'), N_EXPERTS - 1)
    h_pad = jnp.concatenate([hf, jnp.zeros((1, d), hf.dtype)], 0)

    def expert_block(args):
        rows, e = args
        xb = h_pad[rows]
        gu = xb @ w_gate_up[e] + b_gate_up[e]
        return _clamped_swiglu(gu) @ w_down[e] + b_down[e]

    out = lax.map(expert_block, (row_token.reshape(n_blocks, MOE_BLOCK), block_expert))
    out = out.reshape(n_rows, d) * row_weight.astype(out.dtype)[:, None]
    y = jnp.zeros((m + 1, d), out.dtype).at[row_token].add(out)[:m]
    return y.reshape(b, s, d)


def _mixer(u, positions, layer, w_in, conv_w, dn_a_log, dn_dt_bias, dn_norm_w, w_dn_proj,
           lambda_q1, lambda_k1, lambda_q2, lambda_k2, da_norm_w, w_da_proj, w_o):
    b, s, _ = u.shape
    proj = u @ w_in
    qkv_end = IN_OFFSETS[2]
    qkv = jax.nn.silu(_causal_depthwise_conv(proj[..., :qkv_end], conv_w))
    dq, dk, dv = jnp.split(qkv, 3, axis=-1)
    z, b_logit, a_in, aq, ak, av, g_dn, g_da = jnp.split(
        proj[..., qkv_end:], [o - qkv_end for o in IN_OFFSETS[3:]], axis=-1)

    dq = _l2_normalize(dq.reshape(b, s, DN_HEADS, DN_HEAD_DIM)) * (DN_HEAD_DIM ** -0.5)
    dk = _l2_normalize(dk.reshape(b, s, DN_HEADS, DN_HEAD_DIM))
    dv = dv.reshape(b, s, DN_HEADS, DN_HEAD_DIM)
    beta = jax.nn.sigmoid(b_logit.astype(jnp.float32))
    g = -jnp.exp(dn_a_log.astype(jnp.float32)) * jax.nn.softplus(
        a_in.astype(jnp.float32) + dn_dt_bias.astype(jnp.float32))
    o_dn = _gated_delta_rule(dq, dk, dv, g, beta)
    o_dn = _rms_norm(o_dn, dn_norm_w) * jax.nn.silu(z.reshape(b, s, DN_HEADS, DN_HEAD_DIM))
    y_dn = o_dn.reshape(b, s, DN_WIDTH) @ w_dn_proj

    lam_init = 0.8 - 0.6 * math.exp(-0.3 * layer)
    lam = (jnp.exp(jnp.sum(lambda_q1.astype(jnp.float32) * lambda_k1.astype(jnp.float32)))
           - jnp.exp(jnp.sum(lambda_q2.astype(jnp.float32) * lambda_k2.astype(jnp.float32))) + lam_init)
    aq = _rope(aq.reshape(b, s, DA_HEADS, 2, DA_HEAD_DIM), positions)
    ak = _rope(ak.reshape(b, s, DA_HEADS, 2, DA_HEAD_DIM), positions)
    av = av.reshape(b, s, DA_HEADS, 2 * DA_HEAD_DIM)
    o_da = _diff_attention(aq, ak, av, lam)
    o_da = _rms_norm(o_da, da_norm_w) * (1.0 - lam_init)
    y_da = o_da.reshape(b, s, DA_WIDTH) @ w_da_proj

    merged = jax.nn.sigmoid(g_dn) * y_dn + jax.nn.sigmoid(g_da) * y_da
    return merged @ w_o


def setup_inputs(seed: int = 0) -> dict:
    key = jax.random.key(seed)
    keys = jax.random.split(key, 48)
    counter = [0]

    def nxt():
        k = keys[counter[0]]
        counter[0] += 1
        return k

    def nrm(shape, scale):
        return jax.random.normal(nxt(), shape, jnp.float32) * scale

    L, D = DEPTH, D_MODEL
    beta = _deepnorm_beta()
    x = nrm((BATCH, SEQ, D), 1.0)
    c = nrm((BATCH, D), 1.0)
    positions = jnp.broadcast_to(jnp.arange(SEQ, dtype=jnp.int32), (BATCH, SEQ))
    w_ada = nrm((L, D, N_MODS * D), D ** -0.5)
    b_ada = nrm((L, N_MODS * D), 0.02)
    in_gains = (1.0, 1.0, beta, 1.0, 1.0, 1.0, 1.0, 1.0, beta, 1.0, 1.0)
    w_in = jnp.concatenate([nrm((L, D, n), gn * D ** -0.5) for n, gn in zip(IN_SIZES, in_gains)], -1)
    conv_w = nrm((L, CONV_WIDTH, 3 * DN_WIDTH), CONV_WIDTH ** -0.5)
    dn_a_log = jnp.log(jax.random.uniform(nxt(), (L, DN_HEADS), jnp.float32, 1.0, 16.0))
    dt = jnp.exp(jax.random.uniform(nxt(), (L, DN_HEADS), jnp.float32)
                 * (math.log(0.1) - math.log(0.001)) + math.log(0.001))
    dn_dt_bias = dt + jnp.log(-jnp.expm1(-dt))
    dn_norm_w = 1.0 + nrm((L, DN_HEAD_DIM), 0.02)
    w_dn_proj = nrm((L, DN_WIDTH, D), DN_WIDTH ** -0.5)
    lambda_q1 = nrm((L, DA_HEAD_DIM), 0.1)
    lambda_k1 = nrm((L, DA_HEAD_DIM), 0.1)
    lambda_q2 = nrm((L, DA_HEAD_DIM), 0.1)
    lambda_k2 = nrm((L, DA_HEAD_DIM), 0.1)
    da_norm_w = 1.0 + nrm((L, 2 * DA_HEAD_DIM), 0.02)
    w_da_proj = nrm((L, DA_WIDTH, D), DA_WIDTH ** -0.5)
    w_o = nrm((L, D, D), beta * D ** -0.5)
    ln1_g = 1.0 + nrm((L, D), 0.02)
    ln1_b = nrm((L, D), 0.02)
    w_router = nrm((L, D, N_EXPERTS), D ** -0.5)
    b_router = nrm((L, N_EXPERTS), 0.01)
    w_gate_up = nrm((L, N_EXPERTS, D, 2 * D_EXPERT), beta * D ** -0.5)
    b_gate_up = nrm((L, N_EXPERTS, 2 * D_EXPERT), 0.02)
    w_down = nrm((L, N_EXPERTS, D_EXPERT, D), beta * D_EXPERT ** -0.5)
    b_down = nrm((L, N_EXPERTS, D), 0.02)
    ln2_g = 1.0 + nrm((L, D), 0.02)
    ln2_b = nrm((L, D), 0.02)
    return {'x': x, 'c': c, 'positions': positions, 'w_ada': w_ada, 'b_ada': b_ada, 'w_in': w_in,
            'conv_w': conv_w, 'dn_a_log': dn_a_log, 'dn_dt_bias': dn_dt_bias, 'dn_norm_w': dn_norm_w,
            'w_dn_proj': w_dn_proj, 'lambda_q1': lambda_q1, 'lambda_k1': lambda_k1,
            'lambda_q2': lambda_q2, 'lambda_k2': lambda_k2, 'da_norm_w': da_norm_w,
            'w_da_proj': w_da_proj, 'w_o': w_o, 'ln1_g': ln1_g, 'ln1_b': ln1_b,
            'w_router': w_router, 'b_router': b_router, 'w_gate_up': w_gate_up,
            'b_gate_up': b_gate_up, 'w_down': w_down, 'b_down': b_down, 'ln2_g': ln2_g, 'ln2_b': ln2_b}


def reference(x, c, positions, w_ada, b_ada, w_in, conv_w, dn_a_log, dn_dt_bias, dn_norm_w,
              w_dn_proj, lambda_q1, lambda_k1, lambda_q2, lambda_k2, da_norm_w, w_da_proj, w_o,
              ln1_g, ln1_b, w_router, b_router, w_gate_up, b_gate_up, w_down, b_down, ln2_g, ln2_b):
    alpha = _deepnorm_alpha()
    silu_c = jax.nn.silu(c)
    for l in range(DEPTH):
        mods = (silu_c @ w_ada[l] + b_ada[l])[:, None, :]
        shift_m, scale_m, gate_m, shift_f, scale_f, gate_f = jnp.split(mods, N_MODS, axis=-1)
        u = x * (1.0 + scale_m) + shift_m
        mix = _mixer(u, positions, l, w_in[l], conv_w[l], dn_a_log[l], dn_dt_bias[l], dn_norm_w[l],
                     w_dn_proj[l], lambda_q1[l], lambda_k1[l], lambda_q2[l], lambda_k2[l],
                     da_norm_w[l], w_da_proj[l], w_o[l])
        x = _layer_norm(alpha * x + gate_m * mix, ln1_g[l], ln1_b[l])
        u = x * (1.0 + scale_f) + shift_f
        ffn = _moe(u, w_router[l], b_router[l], w_gate_up[l], b_gate_up[l], w_down[l], b_down[l])
        x = _layer_norm(alpha * x + gate_f * ffn, ln2_g[l], ln2_b[l])
    return x
```

```cpp
#include <hip/hip_runtime.h>
#include <cstdio>
#include <cstdint>
namespace pg8 {
#define PG8_LAS __attribute__((address_space(3)))
typedef unsigned short bf16_t;
typedef short bf16x8 __attribute__((ext_vector_type(8)));
typedef float f32x4 __attribute__((ext_vector_type(4)));
typedef unsigned u32x4 __attribute__((ext_vector_type(4)));
constexpr int BM = 256, BK = 64, HALF = 128, HTB = HALF * BK * 2  , STAGE_BYTES = 8 * HTB, NXCD = 8, WGM = 8;

__host__ __device__ __forceinline__ int lds_byte(int r, int c) { const int st = (r >> 4) * 2 + (c >> 5), rr = r & 15, cc = c & 31, ob = rr * 64 + cc * 2; return st * 1024 + (ob ^ (((ob >> 9) & 1) << 5)); }
__host__ __device__ __forceinline__ void stage_rc(int b, int& R, int& C) { const int st = b / 1024, sb = b % 1024, swz = sb ^ (((sb >> 9) & 1) << 5); R = (st >> 1) * 16 + swz / 64; C = (st & 1) * 32 + (swz % 64) / 2; }
__host__ __device__ __forceinline__ int perm32(int rho) { const int n = rho >> 4, i = rho & 15; return 8 * (i >> 2) + 4 * n + (i & 3); }

struct Unit { int pm, pn, e; };
struct Gemm { const bf16_t* A; const bf16_t* Bt; int M, N, K, lda, ldb; size_t bstride; };

struct StaticOrder {
    int nM, nN, nwg, G, c;
    __host__ __device__ void init(int M, int N, int G_, int c_) { nM = M / BM; nN = N / BM; nwg = nM * nN; G = G_; c = c_; }
    __host__ __device__ bool next(int i, Unit& u) const {
        const long L = (long)i * G + c; if (L >= nwg) return false;
        int wgid = (int)L; { const int q = nwg / NXCD, r = nwg % NXCD, xcd = wgid % NXCD, off = wgid / NXCD; wgid = (xcd < r ? xcd * (q + 1) : r * (q + 1) + (xcd - r) * q) + off; }
        const int nig = WGM * nN, gid = wgid / nig, fm = gid * WGM, gsz = (nM - fm) < WGM ? (nM - fm) : WGM;
        u.pm = fm + ((wgid % nig) % gsz); u.pn = (wgid % nig) / gsz; u.e = 0; return true;
    }
    __device__ __forceinline__ void a_ready(const Unit&) const {}
    __device__ __forceinline__ void done(const Unit&) const {}
};

__device__ __forceinline__ unsigned cvt_pk_bf16(float lo, float hi) { unsigned r; asm volatile("v_cvt_pk_bf16_f32 %0, %1, %2" : "=v"(r) : "v"(lo), "v"(hi)); return r; }
typedef float f32x2 __attribute__((ext_vector_type(2)));
__device__ __forceinline__ f32x2 gelu_pk(f32x2 v) {
    const f32x2 av = __builtin_elementwise_abs(v), d = av * 0.2316418882f + 1.0f;
    f32x2 t; t.x = __builtin_amdgcn_rcpf(d.x); t.y = __builtin_amdgcn_rcpf(d.y);
    f32x2 q = t * 0.5307027145f + (-0.7265760135f); q = q * t + 0.7107068705f; q = q * t + (-0.142248368f); q = q * t + 0.127414796f; q = q * t;
    const f32x2 s = (v * v) * (-0.72134752044f);
    f32x2 e; e.x = __builtin_amdgcn_exp2f(s.x); e.y = __builtin_amdgcn_exp2f(s.y);
    const f32x2 m = v * (q * e), r = v - m;
    f32x2 o; o.x = v.x < 0.f ? m.x : r.x; o.y = v.y < 0.f ? m.y : r.y; return o;
}

template <int ACT  > struct EpiBf16 {
    static constexpr bool PERM = true, AFTER_DRAIN = false; static_assert(ACT == 0 || ACT == 1, "EpiBf16: ACT is 0 (none) or 1 (gelu_pk)");
    bf16_t* O; int ldc; const float* bias; int split_cols; size_t split_stride; float scale0;
    __device__ __forceinline__ void operator()(const f32x4 (&acc)[2][2][4][2], const Unit& u, int wr, int wc, int fr, int fq) const {
        const int row0 = u.pm * BM + wr * 64 + fr; int colt = u.pn * BM; bf16_t* base = O;
        float sc = 1.f; if (split_cols) { const int t = colt / split_cols; base += (size_t)t * split_stride; colt -= t * split_cols; if (t == 0) sc = scale0; }
        const int col0 = colt + wc * 32 + 8 * fq, bcol0 = u.pn * BM + wc * 32 + 8 * fq;
        f32x4 bv[2][2];
#pragma unroll
        for (int bj = 0; bj < 2; ++bj)
#pragma unroll
            for (int n = 0; n < 2; ++n) bv[bj][n] = bias ? *(const f32x4*)(bias + bcol0 + bj * HALF + 4 * n) : (f32x4){0.f, 0.f, 0.f, 0.f};
#pragma unroll
        for (int ai = 0; ai < 2; ++ai)
#pragma unroll
            for (int m = 0; m < 4; ++m) { bf16_t* rowp = base + (size_t)(row0 + ai * HALF + m * 16) * ldc + col0;
#pragma unroll
                for (int bj = 0; bj < 2; ++bj) { f32x4 v0 = acc[ai][bj][m][0] + bv[bj][0], v1 = acc[ai][bj][m][1] + bv[bj][1];
                    if (ACT == 1) { f32x2 a = gelu_pk((f32x2){v0[0], v0[1]}), b = gelu_pk((f32x2){v0[2], v0[3]}), c = gelu_pk((f32x2){v1[0], v1[1]}), d = gelu_pk((f32x2){v1[2], v1[3]});
                        v0 = (f32x4){a.x, a.y, b.x, b.y}; v1 = (f32x4){c.x, c.y, d.x, d.y}; }
                    v0 = v0 * sc; v1 = v1 * sc; u32x4 w; w.x = cvt_pk_bf16(v0[0], v0[1]); w.y = cvt_pk_bf16(v0[2], v0[3]); w.z = cvt_pk_bf16(v1[0], v1[1]); w.w = cvt_pk_bf16(v1[2], v1[3]);
                    *(u32x4*)(rowp + bj * HALF) = w; } }
    }
};
template <class Epi, class Sched, bool ALIGN_EPI = false, bool SP2 = false>
__device__ __forceinline__ void gemm_phase(PG8_LAS unsigned char* lds, const Gemm g, const Sched& S, const Epi& E) {
    int tid = threadIdx.x; asm volatile("" : "+v"(tid)); const int wid = __builtin_amdgcn_readfirstlane(tid >> 6), lane = tid & 63, wr = wid >> 2, wc = wid & 3, fr = lane & 15, fq = lane >> 4;
    const int K = g.K, nt = K / BK; const int lda = g.lda, ldb = g.ldb;
    unsigned voffA[2], voffB[2];
#pragma unroll
    for (int i = 0; i < 2; ++i) { int R, C; stage_rc(tid * 16 + i * 8192, R, C); const int Rb = Epi::PERM ? ((R & ~31) + perm32(R & 31)) : R;
        voffA[i] = (unsigned)(R * lda + C) * 2u; voffB[i] = (unsigned)(Rb * ldb + C) * 2u; }
    const size_t kstep = (size_t)(BK * 2);
    const size_t hstepA = (size_t)HALF * lda * 2, hstepB = (size_t)HALF * ldb * 2;
    const size_t tstepA = 2 * hstepA, tstepB = 2 * hstepB;
    const unsigned ldsw = (unsigned)wid * 1024u;
    const int aoff = lds_byte(wr * 64 + fr, fq * 8), boff = lds_byte(wc * 32 + fr, fq * 8);
#define PG8_SA(b, h) (((b) * 2 + (h)) * HTB)
#define PG8_SB(b, h) ((4 + (b) * 2 + (h)) * HTB)
#define PG8_STAGE(bufoff, gbase, voff) do { _Pragma("unroll") for (int _i = 0; _i < 2; ++_i) \
        __builtin_amdgcn_global_load_lds((const unsigned*)((const char*)(gbase) + (voff)[_i]), (PG8_LAS unsigned*)(lds + (bufoff) + ldsw + _i * 8192), 16, 0, 0); } while (0)
#define PG8_LDA(dst, b, h) do { _Pragma("unroll") for (int m = 0; m < 4; ++m) _Pragma("unroll") for (int k = 0; k < 2; ++k) dst[m][k] = *(const PG8_LAS bf16x8*)(lds + PG8_SA(b, h) + aoff + m * 2048 + k * 1024); } while (0)
#define PG8_LDB(dst, b, h) do { _Pragma("unroll") for (int n = 0; n < 2; ++n) _Pragma("unroll") for (int k = 0; k < 2; ++k) dst[n][k] = *(const PG8_LAS bf16x8*)(lds + PG8_SB(b, h) + boff + n * 2048 + k * 1024); } while (0)
#define PG8_MMA(ai, bj, At, Bt) do { __builtin_amdgcn_s_setprio(1); _Pragma("unroll") for (int m = 0; m < 4; ++m) _Pragma("unroll") for (int n = 0; n < 2; ++n) _Pragma("unroll") for (int k = 0; k < 2; ++k) \
        acc[ai][bj][m][n] = __builtin_amdgcn_mfma_f32_16x16x32_bf16(Bt[n][k], At[m][k], acc[ai][bj][m][n], 0, 0, 0); __builtin_amdgcn_s_setprio(0); } while (0)
#define PG8_WAIT_V(n) asm volatile("s_waitcnt vmcnt(" #n ")" ::: "memory")
#define PG8_WAIT_L(n) asm volatile("s_waitcnt lgkmcnt(" #n ")" ::: "memory")
#define PG8_BAR __builtin_amdgcn_s_barrier()
#define PG8_SCHED __builtin_amdgcn_sched_barrier(0)
    Unit cur, nxt; int ui = 0;
    if (!S.next(0, cur)) return;
    f32x4 acc[2][2][4][2];
#pragma unroll
    for (int a = 0; a < 2; ++a)
#pragma unroll
        for (int b = 0; b < 2; ++b)
#pragma unroll
            for (int m = 0; m < 4; ++m)
#pragma unroll
                for (int n = 0; n < 2; ++n) acc[a][b][m][n] = (f32x4){0.f, 0.f, 0.f, 0.f};
    bf16x8 At[4][2], B0[2][2], B1[2][2];
    const char* cA = (const char*)g.A + (size_t)cur.pm * tstepA; const char* cB = (const char*)g.Bt + (size_t)cur.e * g.bstride + (size_t)cur.pn * tstepB;
    S.a_ready(cur);
    if constexpr (SP2) {
        PG8_STAGE(PG8_SB(0, 0), cB, voffB); PG8_STAGE(PG8_SB(0, 1), cB + hstepB, voffB); PG8_STAGE(PG8_SA(0, 0), cA, voffA); PG8_STAGE(PG8_SA(0, 1), cA + hstepA, voffA);
        if (wr == 1) PG8_BAR;
        PG8_WAIT_V(2); PG8_BAR;
        PG8_STAGE(PG8_SB(1, 0), cB + kstep, voffB); PG8_STAGE(PG8_SA(1, 0), cA + kstep, voffA); PG8_STAGE(PG8_SB(1, 1), cB + hstepB + kstep, voffB);
        PG8_WAIT_V(6); PG8_BAR;
    } else {
        PG8_STAGE(PG8_SB(0, 0), cB, voffB); PG8_STAGE(PG8_SA(0, 0), cA, voffA); PG8_STAGE(PG8_SB(0, 1), cB + hstepB, voffB); PG8_STAGE(PG8_SA(0, 1), cA + hstepA, voffA);
        if (wr == 1) PG8_BAR;
        PG8_WAIT_V(4); PG8_BAR;
        PG8_STAGE(PG8_SB(1, 0), cB + kstep, voffB); PG8_STAGE(PG8_SA(1, 0), cA + kstep, voffA); PG8_STAGE(PG8_SB(1, 1), cB + hstepB + kstep, voffB);
        PG8_WAIT_V(6); PG8_BAR;
    }
    for (;;) {
        const bool has_next = S.next(ui + 1, nxt);
        const char* nA = has_next ? (const char*)g.A + (size_t)nxt.pm * tstepA : cA; const char* nB = has_next ? (const char*)g.Bt + (size_t)nxt.e * g.bstride + (size_t)nxt.pn * tstepB : cB;
        for (int t = 0; t < nt; t += 2) {
            const bool last = (t == nt - 2);
            const char* a1 = cA + (size_t)(t + 1) * kstep;
            const char* a2 = last ? nA : cA + (size_t)(t + 2) * kstep; const char* b2 = last ? nB : cB + (size_t)(t + 2) * kstep;
            const char* a3 = a2 + kstep; const char* b3 = b2 + kstep;
            if (last && has_next) S.a_ready(nxt);
            if constexpr (SP2) {
            PG8_LDB(B0, 0, 0); PG8_LDB(B1, 0, 1); PG8_SCHED; PG8_LDA(At, 0, 0); PG8_STAGE(PG8_SA(1, 1), a1 + hstepA, voffA);
            PG8_WAIT_V(8); PG8_WAIT_L(0); PG8_BAR; PG8_MMA(0, 0, At, B0); PG8_MMA(0, 1, At, B1); PG8_BAR; PG8_SCHED;
            PG8_LDA(At, 0, 1); PG8_STAGE(PG8_SB(0, 0), b2, voffB); PG8_STAGE(PG8_SB(0, 1), b2 + hstepB, voffB); PG8_STAGE(PG8_SA(0, 0), a2, voffA);
            PG8_WAIT_V(8); PG8_WAIT_L(0); PG8_BAR; PG8_MMA(1, 0, At, B0); PG8_MMA(1, 1, At, B1); PG8_BAR; PG8_SCHED;
            PG8_LDB(B0, 1, 0); PG8_LDB(B1, 1, 1); PG8_SCHED; PG8_LDA(At, 1, 0); PG8_STAGE(PG8_SA(0, 1), a2 + hstepA, voffA);
            PG8_WAIT_V(8); PG8_WAIT_L(0); PG8_BAR; PG8_MMA(0, 0, At, B0); PG8_MMA(0, 1, At, B1); PG8_BAR; PG8_SCHED;
            PG8_LDA(At, 1, 1); PG8_STAGE(PG8_SB(1, 0), b3, voffB); PG8_STAGE(PG8_SB(1, 1), b3 + hstepB, voffB); PG8_STAGE(PG8_SA(1, 0), a3, voffA);
            PG8_WAIT_V(8); PG8_WAIT_L(0); PG8_BAR; PG8_MMA(1, 0, At, B0); PG8_MMA(1, 1, At, B1); PG8_BAR; PG8_SCHED;
            } else {
            PG8_LDB(B0, 0, 0); PG8_SCHED; PG8_LDA(At, 0, 0); PG8_STAGE(PG8_SA(1, 1), a1 + hstepA, voffA);
            PG8_WAIT_L(8); PG8_BAR; PG8_WAIT_L(0); PG8_MMA(0, 0, At, B0); PG8_BAR; PG8_SCHED;
            PG8_LDB(B1, 0, 1); PG8_STAGE(PG8_SB(0, 0), b2, voffB);
            PG8_BAR; PG8_WAIT_L(0); PG8_MMA(0, 1, At, B1); PG8_BAR;
            PG8_LDA(At, 0, 1); PG8_STAGE(PG8_SA(0, 0), a2, voffA);
            PG8_BAR; PG8_WAIT_L(0); PG8_MMA(1, 0, At, B0); PG8_BAR; PG8_SCHED;
            PG8_STAGE(PG8_SB(0, 1), b2 + hstepB, voffB);
            PG8_WAIT_V(6); PG8_BAR; PG8_MMA(1, 1, At, B1); PG8_BAR;
            PG8_LDB(B0, 1, 0); PG8_SCHED; PG8_LDA(At, 1, 0); PG8_STAGE(PG8_SA(0, 1), a2 + hstepA, voffA);
            PG8_WAIT_L(8); PG8_BAR; PG8_WAIT_L(0); PG8_MMA(0, 0, At, B0); PG8_BAR; PG8_SCHED;
            PG8_LDB(B1, 1, 1); PG8_STAGE(PG8_SB(1, 0), b3, voffB);
            PG8_BAR; PG8_WAIT_L(0); PG8_MMA(0, 1, At, B1); PG8_BAR;
            PG8_LDA(At, 1, 1); PG8_STAGE(PG8_SA(1, 0), a3, voffA);
            PG8_BAR; PG8_WAIT_L(0); PG8_MMA(1, 0, At, B0); PG8_BAR; PG8_SCHED;
            PG8_STAGE(PG8_SB(1, 1), b3 + hstepB, voffB);
            PG8_WAIT_V(6); PG8_BAR; PG8_MMA(1, 1, At, B1); PG8_BAR;
            }
        }
        if constexpr (ALIGN_EPI) { if (wr == 0) PG8_BAR; }
        if constexpr (!Epi::AFTER_DRAIN) { E(acc, cur, wr, wc, fr, fq); S.done(cur); }
        if (!has_next) break;
#pragma unroll
        for (int a = 0; a < 2; ++a)
#pragma unroll
            for (int b = 0; b < 2; ++b)
#pragma unroll
                for (int m = 0; m < 4; ++m)
#pragma unroll
                    for (int n = 0; n < 2; ++n) acc[a][b][m][n] = (f32x4){0.f, 0.f, 0.f, 0.f};
        cur = nxt; cA = nA; cB = nB; ++ui;
        if constexpr (ALIGN_EPI) { if (wr == 1) PG8_BAR; }
    }
    PG8_WAIT_V(0);
    if constexpr (!ALIGN_EPI) { if (wr == 0) PG8_BAR; }
    PG8_BAR;
    if constexpr (Epi::AFTER_DRAIN) { E.fused(acc, cur, wr, wc, fr, fq, lds, wid, lane); S.done(cur); }
#undef PG8_SA
#undef PG8_SB
#undef PG8_STAGE
#undef PG8_LDA
#undef PG8_LDB
#undef PG8_MMA
#undef PG8_WAIT_V
#undef PG8_WAIT_L
#undef PG8_BAR
#undef PG8_SCHED
}
}
#include <hip/hip_bf16.h>
#include <cmath>
namespace attn_body {
using bf16=__hip_bfloat16;
using bf16x8=__attribute__((ext_vector_type(8)))short;
using s16x4=__attribute__((ext_vector_type(4)))short;
using f32x16=__attribute__((ext_vector_type(16)))float;
using u32x4=__attribute__((ext_vector_type(4)))unsigned;
constexpr int SEQ=16384,D=64,DMQ=512,DMV=5632,DMO=1024;
constexpr int NW=8,QBLK=32,QB=QBLK*NW,KVBLK=64,NQB=SEQ/QB;
__device__ __forceinline__ int crow(int r,int hi){return (r&3)+8*(r>>2)+4*hi;}
#define SBAR() __builtin_amdgcn_sched_barrier(0)
__device__ __forceinline__ void cmask(f32x16&p0,f32x16&p1,int jb,int qrel,int hi){
  const float NEG=-INFINITY; int kb=64*jb+4*hi;
  #pragma unroll
  for(int r=0;r<16;++r){int kv=kb+(r&3)+8*(r>>2); if(kv>qrel)p0[r]=NEG; if(kv+32>qrel)p1[r]=NEG;}
}

constexpr int NSLOT=3, SLOTB=8192;
constexpr int LDS_K=0, LDS_V=NSLOT*SLOTB, LDS_WS=2*NSLOT*SLOTB, LDS_OST=LDS_WS+NW*64*4, LDS_BYTES=LDS_OST+NW*4096;
constexpr float C2=0.125f*1.4426950408889634f;
__device__ __forceinline__ void glds16(const void*gsrc,unsigned lds_dst){unsigned keep;
  asm volatile("s_mov_b32 %0, m0\n\ts_mov_b32 m0, %2\n\ts_nop 0\n\tglobal_load_lds_dwordx4 %1, off\n\ts_mov_b32 m0, %0":"=&s"(keep):"v"(gsrc),"s"(lds_dst):"memory");}
__device__ __forceinline__ float max3f(float a,float b,float c){float r;asm("v_max3_f32 %0, %1, %2, %3":"=v"(r):"v"(a),"v"(b),"v"(c));return r;}
__device__ __forceinline__ float max2f(float a,float b){float r;asm("v_max_f32_e32 %0, %1, %2":"=v"(r):"v"(a),"v"(b));return r;}
__device__ __forceinline__ float fadd_s(float a,float b){float r;asm("v_add_f32_e32 %0, %1, %2":"=v"(r):"v"(a),"v"(b));return r;}
__device__ __forceinline__ float fsub_s(float a,float b){float r;asm("v_sub_f32_e32 %0, %1, %2":"=v"(r):"v"(a),"v"(b));return r;}
typedef float f32x2_t __attribute__((ext_vector_type(2))); typedef __bf16 bf16x2_t __attribute__((ext_vector_type(2)));
__device__ __forceinline__ unsigned cvtpk_s(float lo,float hi){f32x2_t v={lo,hi};bf16x2_t b=__builtin_convertvector(v,bf16x2_t);return __builtin_bit_cast(unsigned,b);}
#define WAIT_BAR(N) asm volatile("s_waitcnt vmcnt(" #N ") lgkmcnt(0)\n\ts_barrier":::"memory")

__device__ __forceinline__ void qkt(f32x16&p0,f32x16&p1,const char*Kslot,const bf16x8*qr,const f32x16&negm,int r32,int hi){
  const char*kb=Kslot+hi*1024+r32*16;
  #pragma unroll
  for(int d0=0;d0<4;++d0){
    const bf16x8 b0=*reinterpret_cast<const bf16x8*>(kb+d0*2048);
    const bf16x8 b1=*reinterpret_cast<const bf16x8*>(kb+d0*2048+512);
    if(d0==0){p0=__builtin_amdgcn_mfma_f32_32x32x16_bf16(b0,qr[0],negm,0,0,0);p1=__builtin_amdgcn_mfma_f32_32x32x16_bf16(b1,qr[0],negm,0,0,0);}
    else{p0=__builtin_amdgcn_mfma_f32_32x32x16_bf16(b0,qr[d0],p0,0,0,0);p1=__builtin_amdgcn_mfma_f32_32x32x16_bf16(b1,qr[d0],p1,0,0,0);}}
}
typedef __attribute__((address_space(3))) const char* lds_cptr;
typedef short v4i16_t __attribute__((ext_vector_type(4)));
__device__ __forceinline__ void kload8(bf16x8*kf,lds_cptr kp){
  kf[0]=*(const __attribute__((address_space(3))) bf16x8*)(kp);      kf[1]=*(const __attribute__((address_space(3))) bf16x8*)(kp+512);
  kf[2]=*(const __attribute__((address_space(3))) bf16x8*)(kp+2048); kf[3]=*(const __attribute__((address_space(3))) bf16x8*)(kp+2560);
  kf[4]=*(const __attribute__((address_space(3))) bf16x8*)(kp+4096); kf[5]=*(const __attribute__((address_space(3))) bf16x8*)(kp+4608);
  kf[6]=*(const __attribute__((address_space(3))) bf16x8*)(kp+6144); kf[7]=*(const __attribute__((address_space(3))) bf16x8*)(kp+6656);
}
__device__ __forceinline__ void kload2(bf16x8*kf,lds_cptr kp,int j){ kf[2*j]=*(const __attribute__((address_space(3))) bf16x8*)(kp+j*2048); kf[2*j+1]=*(const __attribute__((address_space(3))) bf16x8*)(kp+j*2048+512); }
__device__ __forceinline__ s16x4 vtr(lds_cptr p){ return __builtin_bit_cast(s16x4,__builtin_amdgcn_ds_read_tr16_b64_v4i16((__attribute__((address_space(3))) v4i16_t*)p)); }
__device__ __forceinline__ float rowmax(const f32x16&p0,const f32x16&p1){
  float a=max3f(p0[0],p0[1],p1[0]),b=max3f(p0[2],p0[3],p1[1]);a=max3f(a,p1[2],p1[3]);
  #pragma unroll
  for(int r=4;r<16;r+=4){a=max3f(a,p0[r],p0[r+1]);b=max3f(b,p0[r+2],p0[r+3]);a=max3f(a,p1[r],p1[r+1]);b=max3f(b,p1[r+2],p1[r+3]);}
  const float m=max2f(a,b);
  auto rr=__builtin_amdgcn_permlane32_swap(__float_as_uint(m),__float_as_uint(m),false,false);
  return max2f(__uint_as_float(rr[0]),__uint_as_float(rr[1]));
}
__device__ __forceinline__ void pv(f32x16*o,int vb,bf16x8 pa0,bf16x8 pa1,bf16x8 pa2,bf16x8 pa3){
  #pragma unroll
  for(int d0=0;d0<2;++d0){s16x4 lo[4],hi[4];
    #pragma unroll
    for(int ks=0;ks<4;++ks){
      asm volatile("ds_read_b64_tr_b16 %0,%1 offset:%c2":"=&v"(lo[ks]):"v"(vb),"i"(d0*4096+ks*1024):"memory");
      asm volatile("ds_read_b64_tr_b16 %0,%1 offset:%c2":"=&v"(hi[ks]):"v"(vb),"i"(d0*4096+ks*1024+512):"memory");}
    asm volatile("s_waitcnt lgkmcnt(0)":::"memory");SBAR();
    #define PK(k) (bf16x8){lo[k][0],lo[k][1],lo[k][2],lo[k][3],hi[k][0],hi[k][1],hi[k][2],hi[k][3]}
    o[d0]=__builtin_amdgcn_mfma_f32_32x32x16_bf16(pa0,PK(0),o[d0],0,0,0);
    o[d0]=__builtin_amdgcn_mfma_f32_32x32x16_bf16(pa1,PK(1),o[d0],0,0,0);
    o[d0]=__builtin_amdgcn_mfma_f32_32x32x16_bf16(pa2,PK(2),o[d0],0,0,0);
    o[d0]=__builtin_amdgcn_mfma_f32_32x32x16_bf16(pa3,PK(3),o[d0],0,0,0);
    #undef PK
  }
}

#ifndef ATTN_STORE16
#define ATTN_STORE16(p,v) (*(u32x4*)(p)=(v))
#endif
template<int THRL> __device__ __forceinline__ void attn_unit(int qcol,int vcol,int ocol,int qb,const bf16*Q,const bf16*__restrict__ K,const bf16*__restrict__ V,bf16*O,char*shm){
  int tid=threadIdx.x; asm volatile("":"+v"(tid)); const int lane=tid&63,r32=lane&31,hi=lane>>5; const int wid=__builtin_amdgcn_readfirstlane(tid>>6);
  const int q0=qb*QB;
  const bf16*Qw=Q+(long)(q0+wid*QBLK)*DMQ+qcol;
  const bf16*Kh=K+qcol,*Vh=V+vcol;
  const unsigned lds0=(unsigned)(uintptr_t)shm;
  float*wsf=(float*)(shm+LDS_WS)+wid*64;
  const bf16*ksrc=Kh+(long)lane*DMQ+wid*8;
  const bf16*vsrc=Vh+(long)(16*(wid&3)+(lane>>2))*DMV+(wid>>2)*32+(lane&3)*8;
  const unsigned kdst=lds0+LDS_K+wid*1024, vdst=lds0+LDS_V+wid*1024;
  #define DMA_K(t,slot) glds16(ksrc+(long)(t)*KVBLK*DMQ,(unsigned)__builtin_amdgcn_readfirstlane(kdst+(slot)))
  #define DMA_V(t,slot) glds16(vsrc+(long)(t)*KVBLK*DMV,(unsigned)__builtin_amdgcn_readfirstlane(vdst+(slot)))
  const int vb0=(int)(lds0+LDS_V)+((lane>>4)&1)*32+(lane&3)*8+(4*hi+((lane&15)>>2))*64;
  const char*Kbase=shm+LDS_K; bf16x8 kf[8];
  const lds_cptr shm3=(lds_cptr)shm; const lds_cptr kp0=shm3+LDS_K+hi*1024+r32*16; const lds_cptr vp0=shm3+LDS_V+((lane>>4)&1)*32+(lane&3)*8+(4*hi+((lane&15)>>2))*64;
  const int NT=(q0+QB)/KVBLK;
  DMA_K(0,0);DMA_V(0,0);DMA_K(1,SLOTB);
  bf16x8 qr[4];
  #pragma unroll
  for(int d0=0;d0<4;++d0)qr[d0]=*reinterpret_cast<const bf16x8*>(&Qw[(long)r32*DMQ+d0*16+hi*8]);
  float mhat=0.f,l_reg=0.f;f32x16 o[2];o[0]=f32x16{};o[1]=f32x16{};f32x16 negm=f32x16{};asm volatile("":"+v"(negm));
  const int qrel=wid*QBLK+r32;
  #define CMASK(P0,P1,t) do{int jb_=(t)-(NT-4); if(jb_>=0)cmask(P0,P1,jb_,qrel,hi);}while(0)
  bool resc=false;
  #define START(P0,P1) do{ const float rm=rowmax(P0,P1); resc=false; \
    { const float dl=rm; mhat=fadd_s(mhat,dl); \
      _Pragma("unroll") for(int r=0;r<16;++r){P0[r]=fsub_s(P0[r],dl);P1[r]=fsub_s(P1[r],dl);} \
      _Pragma("unroll") for(int r=0;r<16;++r)negm[r]=-mhat; asm volatile("":"+v"(negm)); } \
    _Pragma("unroll") for(int r=0;r<16;++r)P0[r]=__builtin_amdgcn_exp2f(P0[r]); }while(0)
  #define RESC() do{ if(resc){ asm volatile("s_waitcnt lgkmcnt(0)":::"memory"); \
      _Pragma("unroll") for(int d_=0;d_<2;++d_) _Pragma("unroll") for(int r=0;r<16;++r)o[d_][r]*=wsf[crow(r,hi)]; } }while(0)
  f32x16 pA0,pA1,pB0,pB1;
  int sl_prev=0,sl_cur=0,sl_next=SLOTB;
  #define ROT() do{sl_prev=sl_cur;sl_cur=sl_next;sl_next=(sl_next==(NSLOT-1)*SLOTB)?0:sl_next+SLOTB;}while(0)
  DMA_K(2,2*SLOTB);
  WAIT_BAR(3);
  qkt(pA0,pA1,Kbase,qr,negm,r32,hi);asm volatile("s_nop 15\n\ts_nop 7":"+v"(pA0),"+v"(pA1));CMASK(pA0,pA1,0);
  START(pA0,pA1);
  _Pragma("unroll") for(int r=0;r<16;++r)pA1[r]=__builtin_amdgcn_exp2f(pA1[r]);
  WAIT_BAR(0);
  DMA_K(3,0);DMA_V(1,SLOTB);
  ROT();
  kload8(kf,kp0+sl_cur);
  WAIT_BAR(2);
  s16x4 vlo[8],vhi[8]; u32x4 pw0,pw1,pw2,pw3;
  #define PKW(P,B) cvtpk_s(P[B],P[B+1])
  #define PAF(k) __builtin_bit_cast(bf16x8,pw##k)
  #define VFR(i) (bf16x8){vlo[i][0],vlo[i][1],vlo[i][2],vlo[i][3],vhi[i][0],vhi[i][1],vhi[i][2],vhi[i][3]}
  #define PIN(x) asm volatile("":"+v"(x))
  #define MX3(a,b,c) __builtin_fmaxf(__builtin_fmaxf((a),(b)),(c))
  #define GAPA(MF,A0,A1,A2,A3,W0,W1,PW) do{ MF; sacc+=A0; sacc+=A1; sacc+=A2; sacc+=A3; PIN(sacc); W0; W1; PIN(PW); SBAR(); }while(0)
  #define EX(v) __builtin_amdgcn_exp2f(v)
  #define GAPB(MF,X,B) do{ MF; X[B]=EX(X[B]); X[B+1]=EX(X[B+1]); X[B+2]=EX(X[B+2]); X[B+3]=EX(X[B+3]); PIN(X); SBAR(); }while(0)
  #define VRD(i) do{ vlo[i]=vtr(vp_+(((i)>>2)*4096+((i)&3)*1024)); vhi[i]=vtr(vp_+(((i)>>2)*4096+((i)&3)*1024+512)); }while(0)
  #define KRD(G,j) do{ if(G){ kload2(kf,kp0+sl_next,j); SBAR(); } }while(0)
  #define STEP(C0,C1,P0,P1,t,GK,GV,GL) do{ SBAR(); \
    const lds_cptr vp_=vp0+sl_prev; \
    VRD(0); SBAR(); float sacc=(P0[0]+P0[1]); \
    GAPA(C0=__builtin_amdgcn_mfma_f32_32x32x16_bf16(kf[0],qr[0],negm,0,0,0), P0[2],P0[3],P0[4],P0[5],     pw0[0]=PKW(P0,0), pw0[1]=PKW(P0,2), pw0); \
    VRD(4); SBAR(); GAPA(C1=__builtin_amdgcn_mfma_f32_32x32x16_bf16(kf[1],qr[0],negm,0,0,0), P0[6],P0[7],P0[8],P0[9],     pw0[2]=PKW(P0,4), pw0[3]=PKW(P0,6), pw0); \
    VRD(1); SBAR(); GAPA(C0=__builtin_amdgcn_mfma_f32_32x32x16_bf16(kf[2],qr[1],C0,0,0,0),   P0[10],P0[11],P0[12],P0[13], pw1[0]=PKW(P0,8), pw1[1]=PKW(P0,10), pw1); \
    VRD(5); SBAR(); GAPA(C1=__builtin_amdgcn_mfma_f32_32x32x16_bf16(kf[3],qr[1],C1,0,0,0),   P0[14],P0[15],P1[0],P1[1],   pw1[2]=PKW(P0,12),pw1[3]=PKW(P0,14), pw1); \
    VRD(2); SBAR(); GAPA(C0=__builtin_amdgcn_mfma_f32_32x32x16_bf16(kf[4],qr[2],C0,0,0,0),   P1[2],P1[3],P1[4],P1[5],     pw2[0]=PKW(P1,0), pw2[1]=PKW(P1,2), pw2); \
    VRD(6); SBAR(); GAPA(C1=__builtin_amdgcn_mfma_f32_32x32x16_bf16(kf[5],qr[2],C1,0,0,0),   P1[6],P1[7],P1[8],P1[9],     pw2[2]=PKW(P1,4), pw2[3]=PKW(P1,6), pw2); \
    VRD(3); SBAR(); GAPA(C0=__builtin_amdgcn_mfma_f32_32x32x16_bf16(kf[6],qr[3],C0,0,0,0),   P1[10],P1[11],P1[12],P1[13], pw3[0]=PKW(P1,8), pw3[1]=PKW(P1,10), pw3); \
    VRD(7); SBAR(); GAPA(C1=__builtin_amdgcn_mfma_f32_32x32x16_bf16(kf[7],qr[3],C1,0,0,0),   P1[14],P1[15],0.f,0.f,       pw3[2]=PKW(P1,12),pw3[3]=PKW(P1,14), pw3); \
    l_reg+=sacc; \
    if(GK){DMA_K((t)+3,sl_cur);} if(GV){DMA_V((t)+1,sl_next);} \
    CMASK(C0,C1,t); \
    { float a=MX3(C0[0],C0[1],C1[0]),b=MX3(C0[2],C0[3],C1[1]); a=MX3(a,C1[2],C1[3]); \
      _Pragma("unroll") for(int r=4;r<16;r+=4){a=MX3(a,C0[r],C0[r+1]);b=MX3(b,C0[r+2],C0[r+3]);a=MX3(a,C1[r],C1[r+1]);b=MX3(b,C1[r+2],C1[r+3]);} \
      float rm=__builtin_fmaxf(a,b); { auto rr=__builtin_amdgcn_permlane32_swap(__float_as_uint(rm),__float_as_uint(rm),false,false); rm=__builtin_fmaxf(__uint_as_float(rr[0]),__uint_as_float(rr[1])); } \
      resc=false; \
      if(__builtin_expect(__any(rm>(float)THRL),0)){ const float dl=__builtin_fmaxf(rm,0.f); mhat+=dl; \
        _Pragma("unroll") for(int r=0;r<16;++r){C0[r]-=dl;C1[r]-=dl;} \
        _Pragma("unroll") for(int r=0;r<16;++r)negm[r]=-mhat; asm volatile("":"+v"(negm)); \
        const float f=__builtin_amdgcn_exp2f(-dl); l_reg*=f; if(hi==0)wsf[r32]=f; resc=true; } } \
    SBAR(); \
    GAPB(o[0]=__builtin_amdgcn_mfma_f32_32x32x16_bf16(PAF(0),VFR(0),o[0],0,0,0), C0,0); \
    GAPB(o[1]=__builtin_amdgcn_mfma_f32_32x32x16_bf16(PAF(0),VFR(4),o[1],0,0,0), C0,4); \
    KRD(GL,0); GAPB(o[0]=__builtin_amdgcn_mfma_f32_32x32x16_bf16(PAF(1),VFR(1),o[0],0,0,0), C0,8); \
    KRD(GL,1); GAPB(o[1]=__builtin_amdgcn_mfma_f32_32x32x16_bf16(PAF(1),VFR(5),o[1],0,0,0), C0,12); \
    KRD(GL,2); GAPB(o[0]=__builtin_amdgcn_mfma_f32_32x32x16_bf16(PAF(2),VFR(2),o[0],0,0,0), C1,0); \
    KRD(GL,3); GAPB(o[1]=__builtin_amdgcn_mfma_f32_32x32x16_bf16(PAF(2),VFR(6),o[1],0,0,0), C1,4); \
    GAPB(o[0]=__builtin_amdgcn_mfma_f32_32x32x16_bf16(PAF(3),VFR(3),o[0],0,0,0), C1,8); \
    GAPB(o[1]=__builtin_amdgcn_mfma_f32_32x32x16_bf16(PAF(3),VFR(7),o[1],0,0,0), C1,12); \
    }while(0)
  int t=1;
  #undef CMASK
  #define CMASK(P0,P1,t) do{}while(0)
  for(;t+5<NT;t+=2){
    STEP(pB0,pB1,pA0,pA1,t,true,true,true);     WAIT_BAR(2); RESC(); ROT();
    STEP(pA0,pA1,pB0,pB1,t+1,true,true,true);   WAIT_BAR(2); RESC(); ROT();
  }
  #undef CMASK
  #define CMASK(P0,P1,t) do{int jb_=(t)-(NT-4); if(jb_>=0)cmask(P0,P1,jb_,qrel,hi);}while(0)
  #define ENDW(tt) do{ if((tt)+3<NT){WAIT_BAR(2);} else if((tt)+2<NT){WAIT_BAR(1);} else {WAIT_BAR(0);} }while(0)
  for(;t+1<NT;t+=2){
    STEP(pB0,pB1,pA0,pA1,t,(t+3<NT),(t+1<NT),(t+1<NT));       ENDW(t);   RESC(); ROT();
    STEP(pA0,pA1,pB0,pB1,t+1,(t+4<NT),(t+2<NT),(t+2<NT));     ENDW(t+1); RESC(); ROT();
  }
  STEP(pB0,pB1,pA0,pA1,NT-1,false,false,false); RESC();
  { float sacc=pB0[0]+pB0[1]; _Pragma("unroll") for(int r=2;r<16;++r)sacc+=pB0[r]; _Pragma("unroll") for(int r=0;r<16;++r)sacc+=pB1[r]; l_reg+=sacc;
    pw0=(u32x4){PKW(pB0,0),PKW(pB0,2),PKW(pB0,4),PKW(pB0,6)};pw1=(u32x4){PKW(pB0,8),PKW(pB0,10),PKW(pB0,12),PKW(pB0,14)};pw2=(u32x4){PKW(pB1,0),PKW(pB1,2),PKW(pB1,4),PKW(pB1,6)};pw3=(u32x4){PKW(pB1,8),PKW(pB1,10),PKW(pB1,12),PKW(pB1,14)};
    SBAR(); pv(o,vb0+sl_cur,PAF(0),PAF(1),PAF(2),PAF(3)); }
  #undef PKW
  #undef PAF
  #undef VFR
  #undef PIN
  #undef MX3
  #undef GAPA
  #undef GAPB
  #undef EX
  #undef VRD
  #undef KRD
  #undef STEP
  #undef ENDW
  {auto rr=__builtin_amdgcn_permlane32_swap(__float_as_uint(l_reg),__float_as_uint(l_reg),false,false);l_reg=__uint_as_float(rr[0])+__uint_as_float(rr[1]);}
  if(hi==0)wsf[32+r32]=l_reg;asm volatile("s_waitcnt lgkmcnt(0)":::"memory");
  float rli[16];
  #pragma unroll
  for(int r=0;r<16;++r)rli[r]=__builtin_amdgcn_rcpf(wsf[32+crow(r,hi)]);
  bf16*Ow=O+(long)(q0+wid*QBLK)*DMO+ocol;
  { bf16*stg=(bf16*)(shm+LDS_OST)+wid*2048;
    #pragma unroll
    for(int r=0;r<16;++r){const int orow=crow(r,hi);
      #pragma unroll
      for(int d0=0;d0<2;++d0)stg[orow*64+d0*32+r32]=__float2bfloat16(o[d0][r]*rli[r]);}
    asm volatile("s_waitcnt lgkmcnt(0)":::"memory");
    #pragma unroll
    for(int i=0;i<4;++i){const int row=i*8+(lane>>3),ch=lane&7; const u32x4 v=*(const u32x4*)(stg+row*64+ch*8); ATTN_STORE16(Ow+(long)row*DMO+ch*8,v);} }
  asm volatile("s_waitcnt lgkmcnt(0)\n\ts_barrier":::"memory");
  #undef DMA_K
  #undef DMA_V
  #undef CMASK
  #undef START
  #undef RESC
  #undef ROT
}
constexpr int ATTN_LDS_BYTES=LDS_BYTES;
#undef SBAR
#undef WAIT_BAR
}
#define GAS __attribute__((address_space(1)))
#define LAS __attribute__((address_space(3)))
typedef unsigned short bf16;
typedef unsigned v4u __attribute__((ext_vector_type(4)));
typedef float f32x4 __attribute__((ext_vector_type(4)));
typedef short bf16x8 __attribute__((ext_vector_type(8)));
typedef GAS unsigned gu32;
typedef GAS unsigned long long gu64;
#define RLX_AGENT __ATOMIC_RELAXED, __HIP_MEMORY_SCOPE_AGENT
#define LDS_WAIT() asm volatile("s_waitcnt lgkmcnt(0)" ::: "memory")
#define VM_WAIT() asm volatile("s_waitcnt vmcnt(0)" ::: "memory")
__device__ __forceinline__ unsigned long long rt() { return __builtin_amdgcn_s_memrealtime(); }
__device__ __forceinline__ unsigned f2bf(float f) { unsigned u = __builtin_bit_cast(unsigned, f); return (u + 0x7fffu + ((u >> 16) & 1u)) >> 16; }
__device__ __forceinline__ unsigned pk2(float lo, float hi) { return f2bf(lo) | (f2bf(hi) << 16); }

#define XB_TMO      128
#define XB_XCNT(j)  (256  + 64 * (j))
#define XB_XSUB(j)  (1280 + 64 * (j))
#define XB_XGEN(j)  (2304 + 64 * (j))
#define XB_TOP      3328
#define XB_TOPGEN   3392
#define XCD_BAR_WORDS 3456
#define XB_SPIN_CAP (1u << 18)

__device__ __forceinline__ unsigned xb_ld(unsigned* p)              { return __hip_atomic_load(p, __ATOMIC_RELAXED, __HIP_MEMORY_SCOPE_AGENT); }
__device__ __forceinline__ unsigned xb_add(unsigned* p, unsigned v) { return __hip_atomic_fetch_add(p, v, __ATOMIC_RELAXED, __HIP_MEMORY_SCOPE_AGENT); }
__device__ __forceinline__ unsigned xb_xcc_id() { return (unsigned)__builtin_amdgcn_s_getreg((3 << 11) | 20) & 0xFu; }
#define XB_SPIN(cond, bar) do { unsigned _sp = 0; while (cond) { __builtin_amdgcn_s_sleep(1); \
    if ((++_sp & 255u) == 0u) { if (xb_ld(&(bar)[XB_TMO])) break; if (_sp > XB_SPIN_CAP) { atomicAdd(&(bar)[XB_TMO], 1u); break; } } } } while (0)

struct XcdBarrier {
    unsigned* bar; unsigned x;
    volatile LAS unsigned* st;
};

__device__ __forceinline__ XcdBarrier xcd_barrier_post(unsigned* bar, volatile LAS unsigned* st) {
    XcdBarrier b; b.bar = bar; b.x = xb_xcc_id(); b.st = st;
    if (threadIdx.x == 0) (void)xb_add(&bar[XB_XCNT(b.x)], 1u);
    return b;
}
__device__ __forceinline__ void xcd_barrier_complete(unsigned* bar, unsigned x, unsigned& nloc, unsigned& nx) {
    const unsigned G = gridDim.x * gridDim.y * gridDim.z;
    unsigned sum, cnt, mine, sp = 0u;
    for (;;) {
        sum = 0u; cnt = 0u; mine = 0u;
#pragma unroll
        for (unsigned j = 0; j < 16; ++j) { const unsigned c = xb_ld(&bar[XB_XCNT(j)]); sum += c; cnt += (c > 0u) ? 1u : 0u; mine = (j == x) ? c : mine; }
        if (sum == G) break;
        __builtin_amdgcn_s_sleep(1);
        if ((++sp & 255u) == 0u) { if (xb_ld(&bar[XB_TMO])) break; if (sp > XB_SPIN_CAP) { atomicAdd(&bar[XB_TMO], 1u); break; } }
    }
    nloc = mine > 0u ? mine : 1u; nx = cnt > 0u ? cnt : 1u;
}

__device__ __forceinline__ void xcd_barrier(const XcdBarrier& b) {
    asm volatile("s_waitcnt vmcnt(0)" ::: "memory");
    __syncthreads();
    if (threadIdx.x == 0) {
        unsigned* bar = b.bar;
        __builtin_amdgcn_s_waitcnt(0);
        unsigned nloc = b.st[0], nx = b.st[1];
        if (nloc == 0u) { xcd_barrier_complete(bar, b.x, nloc, nx); b.st[0] = nloc; b.st[1] = nx; }
        const unsigned old = xb_add(&bar[XB_XSUB(b.x)], 1u);
        const unsigned gen = old / nloc;
        if (old + 1u == (gen + 1u) * nloc) {
            __builtin_amdgcn_fence(__ATOMIC_RELEASE, "agent");
            asm volatile("s_waitcnt vmcnt(0)" ::: "memory");
            const unsigned og = xb_add(&bar[XB_TOP], 1u);
            const unsigned tg = og / nx;
            if (og + 1u == (tg + 1u) * nx) xb_add(&bar[XB_TOPGEN], 1u);
            else XB_SPIN(xb_ld(&bar[XB_TOPGEN]) == tg, bar);
            __builtin_amdgcn_fence(__ATOMIC_ACQUIRE, "agent");
            xb_add(&bar[XB_XGEN(b.x)], 1u);
            asm volatile("s_waitcnt vmcnt(0)" ::: "memory");
        } else {
            XB_SPIN(xb_ld(&bar[XB_XGEN(b.x)]) == gen, bar);
            __builtin_amdgcn_fence(__ATOMIC_ACQUIRE, "agent");
            asm volatile("s_waitcnt vmcnt(0)" ::: "memory");
        }
    }
    __syncthreads();
}

constexpr int NWAVES = 8, NTHR = 512;
constexpr int M = 16384, D = 1024, NPJ = 5632, WIN_LD = 5640;
constexpr int PJ_DQ = 0, PJ_DK = 512, PJ_DV = 1024, PJ_Z = 1536, PJ_AQ = 2048, PJ_AK = 2560, PJ_AV = 3072, PJ_GDN = 3584, PJ_GDA = 4608;
constexpr int NEXP = 32, MOE_ROWS = 73728, MOE_MAXBLK = 288;
constexpr float LN_EPS = 1e-5f;
constexpr float DN_ALPHA = 1.189207115002721f;
constexpr float LAM_INIT = 0.2f;
constexpr float ATT_C2 = 0.125f * 1.4426950408889634f;

constexpr size_t MiB = 1u << 20;
constexpr size_t WS_CTL = 0, CTL_ZERO_BYTES = 1 * MiB;
constexpr size_t WS_MODSP = 1 * MiB;
constexpr size_t WS_G = 1 * MiB + 65536;
constexpr size_t WS_BETA = WS_G + 4 * M * 4;
constexpr size_t WS_CD = WS_BETA + 4 * M * 4;
constexpr size_t WS_TOKE = 2 * MiB;
constexpr size_t WS_TOKW = WS_TOKE + M * 16;
constexpr size_t WS_TOKR = WS_TOKW + M * 16;
constexpr size_t WS_TOKP = WS_TOKR + M * 16;
constexpr size_t WS_ROWW = 3 * MiB;
constexpr size_t WS_CNT = WS_ROWW + MOE_ROWS * 4;
constexpr size_t WS_BLKE = WS_CNT + 256 * 32 * 4;
constexpr size_t WS_WINT = 8 * MiB;
constexpr size_t WS_WDNT = 19 * MiB, WS_WDAT = 20 * MiB, WS_WOT = 21 * MiB;
constexpr size_t WS_WGUT = 24 * MiB;
constexpr size_t WS_WDT = 152 * MiB;
constexpr size_t WS_X1 = 216 * MiB;
constexpr size_t WS_Z = 280 * MiB;
constexpr size_t WS_H = 344 * MiB;
constexpr size_t WS_MG = 376 * MiB;
constexpr size_t WS_R = 408 * MiB;
constexpr size_t WS_PJ = WS_R;
constexpr size_t WS_U = WS_R + 176 * MiB;
constexpr size_t WS_DNOPS = WS_R + 208 * MiB;
constexpr size_t WS_QR = WS_R + 296 * MiB, WS_KR = WS_R + 312 * MiB;
constexpr size_t WS_OA = WS_R + 328 * MiB;
constexpr size_t WS_ODN = WS_R + 360 * MiB;
constexpr size_t WS_A5 = WS_R + 392 * MiB;
constexpr size_t WS_T = WS_R + 424 * MiB;
constexpr size_t WS_HS = WS_R;
constexpr size_t WS_ACT = WS_R + 144 * MiB;
constexpr size_t WS_EO = WS_R + 288 * MiB;
constexpr size_t WS_END = 1024 * MiB;
static_assert(WS_T + (size_t)M * D * 4 <= WS_END && WS_EO + (size_t)MOE_ROWS * D * 2 <= WS_END, "ws map");
constexpr int DNOPS_BYTES = 90112, DN_WF = 0, DN_QDF = 16384, DN_QKF = 32768, DN_KDF = 40960, DN_UB = 57344;

constexpr int CW_TMO = 0, CW_BAR = 4096, CW_SCANQ = 8192, CW_ATTQ = 8192 + 64;

constexpr int LDS_BYTES = 147456, LDSCTL_OFF = 146432;

typedef unsigned v2u __attribute__((ext_vector_type(2)));
typedef int v4i __attribute__((ext_vector_type(4)));
__device__ __forceinline__ unsigned pkbf(float lo, float hi) { typedef float f2 __attribute__((ext_vector_type(2))); typedef __bf16 b2 __attribute__((ext_vector_type(2))); f2 v = {lo, hi}; b2 b = __builtin_convertvector(v, b2); return __builtin_bit_cast(unsigned, b); }
__device__ __forceinline__ float bflo(unsigned u) { return __uint_as_float(u << 16); }
__device__ __forceinline__ float bfhi(unsigned u) { return __uint_as_float(u & 0xffff0000u); }
__device__ __forceinline__ float wave_sum(float v) {
#pragma unroll
    for (int o = 1; o < 64; o <<= 1) v += __shfl_xor(v, o);
    return v;
}
__device__ __forceinline__ float sigmoidf_(float x) { return 1.f / (1.f + __expf(-x)); }
__device__ __forceinline__ float mods_at(const float* modsp, const float* b_ada, int n) { return modsp[n] + modsp[6144 + n] + b_ada[n]; }
__device__ __forceinline__ f32x4 mods4(const float* modsp, const float* b_ada, int n) {
    const f32x4 a = *(const f32x4*)(modsp + n), b = *(const f32x4*)(modsp + 6144 + n), c = *(const f32x4*)(b_ada + n); return a + b + c; }

__device__ __forceinline__ void p0_mods(const float* c, const float* w_ada, float* modsp, LAS float* red, int lane, int wave) {
    const int b = blockIdx.x;
    if (b < 192) {
        const int cg = b >> 1, kh = b & 1, k0 = kh * 512 + wave * 64;
        const float* wp = w_ada + (size_t)k0 * 6144 + cg * 64 + lane;
        float acc = 0.f;
#pragma unroll 8
        for (int k = 0; k < 64; ++k) { const float cv = c[k0 + k]; const float s = cv / (1.f + expf(-cv)); acc += s * wp[(size_t)k * 6144]; }
        red[wave * 64 + lane] = acc;
        __syncthreads();
        if (wave == 0) { float s = 0.f;
#pragma unroll
            for (int w = 0; w < 8; ++w) s += red[w * 64 + lane];
            modsp[kh * 6144 + cg * 64 + lane] = s; }
        __syncthreads();
    }
}
__device__ __forceinline__ void transpose_tile(const float* W, size_t ldw, int k0, int n0, bf16* WT, size_t ldt, int nd0, LAS float* scr, int lane) {
#pragma unroll 4
    for (int i = 0; i < 16; ++i) { const int k = 4 * i + (lane >> 4), c = 4 * (lane & 15);
        const f32x4 v = *(const GAS f32x4*)(W + (size_t)(k0 + k) * ldw + n0 + c);
        LAS float* s = scr + k * 65 + c; s[0] = v.x; s[1] = v.y; s[2] = v.z; s[3] = v.w; }
    LDS_WAIT(); asm volatile("" ::: "memory");
    const int c = lane & 7;
#pragma unroll
    for (int j = 0; j < 8; ++j) { const int n = (lane >> 3) + 8 * j; const LAS float* s = scr + (8 * c) * 65 + n;
        v4u o; o.x = pkbf(s[0], s[65]); o.y = pkbf(s[130], s[195]); o.z = pkbf(s[260], s[325]); o.w = pkbf(s[390], s[455]);
        *(GAS v4u*)(WT + (size_t)(nd0 + n) * ldt + k0 + 8 * c) = o; }
    LDS_WAIT(); asm volatile("" ::: "memory");
}
template <bool MOE_W>
__device__ __forceinline__ void p0_weights(const float* w_in, const float* w_dn, const float* w_da, const float* w_o, const float* w_gu, const float* w_dw,
                                           unsigned char* ws, LAS unsigned char* lds, int lane, int wave) {
    LAS float* scr = (LAS float*)(lds + wave * 16640);
    const int gw = blockIdx.x * NWAVES + wave, NGW = gridDim.x * NWAVES;
    constexpr int I_IN = 16 * 88, I_DN = 8 * 16, I_O = 16 * 16, I_GU = 32 * 16 * 32, I_DW = 32 * 16 * 16;
    constexpr int NITEMS = I_IN + 2 * I_DN + I_O + (MOE_W ? I_GU + I_DW : 0);
    for (int it = gw; it < NITEMS; it += NGW) {
        int r = it;
        if (r < I_IN) { const int kb = r / 88, nb = r % 88, nd = nb * 64, ns = nd + (nd >= 2048 ? 8 : 0);
            transpose_tile(w_in, WIN_LD, kb * 64, ns, (bf16*)(ws + WS_WINT), 1024, nd, scr, lane); continue; } r -= I_IN;
        if (r < I_DN) { transpose_tile(w_dn, 1024, (r / 16) * 64, (r % 16) * 64, (bf16*)(ws + WS_WDNT), 512, (r % 16) * 64, scr, lane); continue; } r -= I_DN;
        if (r < I_DN) { transpose_tile(w_da, 1024, (r / 16) * 64, (r % 16) * 64, (bf16*)(ws + WS_WDAT), 512, (r % 16) * 64, scr, lane); continue; } r -= I_DN;
        if (r < I_O) { transpose_tile(w_o, 1024, (r / 16) * 64, (r % 16) * 64, (bf16*)(ws + WS_WOT), 1024, (r % 16) * 64, scr, lane); continue; } r -= I_O;
        if (MOE_W) {
            if (r < I_GU) { const int e = r / 512, q = r % 512;
                transpose_tile(w_gu + (size_t)e * 1024 * 2048, 2048, (q / 32) * 64, (q % 32) * 64, (bf16*)(ws + WS_WGUT) + (size_t)e * 2048 * 1024, 1024, (q % 32) * 64, scr, lane); continue; } r -= I_GU;
            { const int e = r / 256, q = r % 256;
                transpose_tile(w_dw + (size_t)e * 1024 * 1024, 1024, (q / 16) * 64, (q % 16) * 64, (bf16*)(ws + WS_WDT) + (size_t)e * 1024 * 1024, 1024, (q % 16) * 64, scr, lane); }
        }
    }
}

__device__ __forceinline__ void p1_modulate(const float* x, const float* w_in, const float* modsp, const float* b_ada, const float* a_log, const float* dt_bias,
                                            unsigned char* ws, LAS unsigned char* lds, int tid, int lane, int wave) {
    LAS float* wba = (LAS float*)lds;
    for (int idx = tid; idx < 8192; idx += NTHR) { const int k = idx >> 3, q = idx & 7; wba[q * 1024 + k] = w_in[(size_t)k * WIN_LD + 2048 + q]; }
    __syncthreads();
    f32x4 sc[4], sh[4];
#pragma unroll
    for (int j = 0; j < 4; ++j) { sh[j] = mods4(modsp, b_ada, 256 * j + 4 * lane); sc[j] = mods4(modsp, b_ada, 1024 + 256 * j + 4 * lane) + 1.0f; }
    const int gw = blockIdx.x * NWAVES + wave, NGW = gridDim.x * NWAVES;
    bf16* U = (bf16*)(ws + WS_U); float* G = (float*)(ws + WS_G); float* BETA = (float*)(ws + WS_BETA);
    for (int m = gw; m < M; m += NGW) {
        const GAS f32x4* xr = (const GAS f32x4*)(x + (size_t)m * D) + lane;
        f32x4 u[4];
#pragma unroll
        for (int j = 0; j < 4; ++j) { u[j] = xr[64 * j] * sc[j] + sh[j]; }
        GAS unsigned long long* o8 = (GAS unsigned long long*)(U + (size_t)m * D) + lane;
#pragma unroll
        for (int j = 0; j < 4; ++j) o8[64 * j] = (unsigned long long)pkbf(u[j].x, u[j].y) | ((unsigned long long)pkbf(u[j].z, u[j].w) << 32);
        float p[8];
#pragma unroll
        for (int q = 0; q < 8; ++q) { float s = 0.f;
#pragma unroll
            for (int j = 0; j < 4; ++j) { const f32x4 w = *(const LAS f32x4*)(wba + q * 1024 + 256 * j + 4 * lane); s += (u[j].x * w.x + u[j].y * w.y) + (u[j].z * w.z + u[j].w * w.w); }
            p[q] = wave_sum(s); }
        if (lane < 4) {
            const float pb = lane == 0 ? p[0] : lane == 1 ? p[1] : lane == 2 ? p[2] : p[3];
            const float pa = lane == 0 ? p[4] : lane == 1 ? p[5] : lane == 2 ? p[6] : p[7];
            const float xx = pa + dt_bias[lane];
            const float sp = xx > 20.f ? xx : log1pf(expf(xx));
            BETA[lane * M + m] = 1.f / (1.f + expf(-pb));
            G[lane * M + m] = -expf(a_log[lane]) * sp;
        }
    }
    __syncthreads();
}

__device__ __forceinline__ void p3_rope_unit(int n, const int* positions, const bf16* PJ, bf16* QR, bf16* KR, int tid) {
    const int t = 64 * n + (tid >> 3), f = tid & 7;
    const float pos = (float)positions[t];
    float cs[4], sn[4];
#pragma unroll
    for (int i = 0; i < 4; ++i) {
        const float invf = powf(10000.0f, -(float)(4 * f + i) / 32.0f);
        const float ang = pos * invf;
        const double rev = (double)ang * 0.15915494309189535;
        const float fr = (float)(rev - rint(rev));
        sn[i] = __builtin_amdgcn_sinf(fr); cs[i] = __builtin_amdgcn_cosf(fr);
    }
    const bf16* src = PJ + (size_t)t * NPJ + PJ_AQ;
#pragma unroll 4
    for (int v = 0; v < 16; ++v) {
        const v2u a = *(const GAS v2u*)(src + 64 * v + 4 * f), b = *(const GAS v2u*)(src + 64 * v + 32 + 4 * f);
        const float x1[4] = {bflo(a.x), bfhi(a.x), bflo(a.y), bfhi(a.y)}, x2[4] = {bflo(b.x), bfhi(b.x), bflo(b.y), bfhi(b.y)};
        const float s = v < 8 ? ATT_C2 : 1.0f;
        float o1[4], o2[4];
#pragma unroll
        for (int i = 0; i < 4; ++i) { o1[i] = (x1[i] * cs[i] - x2[i] * sn[i]) * s; o2[i] = (x2[i] * cs[i] + x1[i] * sn[i]) * s; }
        bf16* dst = (v < 8 ? QR + (size_t)t * 512 + 64 * v : KR + (size_t)t * 512 + 64 * (v - 8));
        v2u r1, r2; r1.x = pkbf(o1[0], o1[1]); r1.y = pkbf(o1[2], o1[3]); r2.x = pkbf(o2[0], o2[1]); r2.y = pkbf(o2[2], o2[3]);
        *(GAS v2u*)(dst + 4 * f) = r1; *(GAS v2u*)(dst + 32 + 4 * f) = r2;
    }
}

#define MFMA16(a, b, c) __builtin_amdgcn_mfma_f32_16x16x32_bf16((a), (b), (c), 0, 0, 0)
__device__ __forceinline__ bf16x8 pack8(const f32x4 a, const f32x4 b) {
    v4u p; p.x = pkbf(a.x, a.y); p.y = pkbf(a.z, a.w); p.z = pkbf(b.x, b.y); p.w = pkbf(b.z, b.w); return __builtin_bit_cast(bf16x8, p); }
constexpr int DP_KF = 0, DP_VF = 33792, DP_QB = 67584, DP_KB = 84992, DP_AM = 102400, DP_SM = 119808;

__device__ __forceinline__ void dn_prep_unit(int n, int h, const bf16* PJ, const float* conv_w, const float* G, const float* BETA, float* CD, unsigned char* dnops_all,
                                             LAS unsigned char* lds, int tid, int lane, int wave) {
    LAS float* KF = (LAS float*)(lds + DP_KF); LAS float* VF = (LAS float*)(lds + DP_VF);
    LAS bf16* QB = (LAS bf16*)(lds + DP_QB); LAS bf16* KB = (LAS bf16*)(lds + DP_KB);
    LAS float* AM = (LAS float*)(lds + DP_AM); LAS float* SM = (LAS float*)(lds + DP_SM);
    unsigned char* ops = dnops_all + (size_t)(h * 256 + n) * DNOPS_BYTES;
    const int fr = lane & 15, fg = lane >> 4;
    if (wave == 7) {
        const float g = G[h * M + 64 * n + lane], be = BETA[h * M + 64 * n + lane];
        float cum = g;
#pragma unroll
        for (int o = 1; o < 64; o <<= 1) { const float t = __shfl_up(cum, o); if (lane >= o) cum += t; }
        const float last = __shfl(cum, 63);
        SM[lane] = cum; SM[64 + lane] = expf(cum); SM[128 + lane] = be; SM[192 + lane] = expf(last - cum); SM[256 + lane] = be * expf(cum);
        if (lane == 63) CD[h * 256 + n] = expf(cum);
    }
    if (tid < 384) {
        const int cg = tid % 48, rg = tid / 48, type = cg >> 4, c8 = (cg & 15) * 8, r0 = 8 * rg;
        const int pjcol = type * 512 + h * 128 + c8;
        float w[4][8];
#pragma unroll
        for (int j = 0; j < 4; ++j) { const f32x4 a = *(const f32x4*)(conv_w + j * 1536 + pjcol), b = *(const f32x4*)(conv_w + j * 1536 + pjcol + 4);
            w[j][0] = a.x; w[j][1] = a.y; w[j][2] = a.z; w[j][3] = a.w; w[j][4] = b.x; w[j][5] = b.y; w[j][6] = b.z; w[j][7] = b.w; }
        v4u xr[11];
#pragma unroll
        for (int r = 0; r < 11; ++r) { const int row = 64 * n + r0 - 3 + r;
            xr[r] = row >= 0 ? *(const GAS v4u*)(PJ + (size_t)row * NPJ + pjcol) : (v4u){0u, 0u, 0u, 0u}; }
#pragma unroll
        for (int i = 0; i < 8; ++i) {
            float o[8];
#pragma unroll
            for (int e = 0; e < 8; ++e) o[e] = 0.f;
#pragma unroll
            for (int j = 0; j < 4; ++j) { const v4u xv = xr[i + j];
                o[0] += w[j][0] * bflo(xv.x); o[1] += w[j][1] * bfhi(xv.x); o[2] += w[j][2] * bflo(xv.y); o[3] += w[j][3] * bfhi(xv.y);
                o[4] += w[j][4] * bflo(xv.z); o[5] += w[j][5] * bfhi(xv.z); o[6] += w[j][6] * bflo(xv.w); o[7] += w[j][7] * bfhi(xv.w); }
            float ss = 0.f;
#pragma unroll
            for (int e = 0; e < 8; ++e) { o[e] = o[e] / (1.f + __expf(-o[e])); ss += o[e] * o[e]; }
            const int row = r0 + i;
            if (type < 2) {
                ss += __shfl_xor(ss, 1); ss += __shfl_xor(ss, 2); ss += __shfl_xor(ss, 4); ss += __shfl_xor(ss, 8);
                const float rn = rsqrtf(ss + 1e-6f) * (type == 0 ? 0.08838834764831845f : 1.0f);
#pragma unroll
                for (int e = 0; e < 8; ++e) o[e] *= rn;
                v4u pk; pk.x = pkbf(o[0], o[1]); pk.y = pkbf(o[2], o[3]); pk.z = pkbf(o[4], o[5]); pk.w = pkbf(o[6], o[7]);
                if (type == 0) *(LAS v4u*)(QB + row * 136 + c8) = pk;
                else { *(LAS v4u*)(KB + row * 136 + c8) = pk;
                    *(LAS f32x4*)(KF + row * 132 + c8) = (f32x4){o[0], o[1], o[2], o[3]}; *(LAS f32x4*)(KF + row * 132 + c8 + 4) = (f32x4){o[4], o[5], o[6], o[7]}; }
            } else {
                *(LAS f32x4*)(VF + row * 132 + c8) = (f32x4){o[0], o[1], o[2], o[3]}; *(LAS f32x4*)(VF + row * 132 + c8 + 4) = (f32x4){o[4], o[5], o[6], o[7]};
            }
        }
    }
    __syncthreads();
#pragma unroll
    for (int rep = 0; rep < 2; ++rep) {
        const int tix = wave + 8 * rep;
        if (tix < 10) {
            const int it = tix < 1 ? 0 : tix < 3 ? 1 : tix < 6 ? 2 : 3, jt = tix - (it * (it + 1)) / 2;
            f32x4 acc = {0.f, 0.f, 0.f, 0.f};
#pragma unroll
            for (int ks = 0; ks < 4; ++ks) {
                const bf16x8 a = *(const LAS bf16x8*)(KB + (16 * it + fr) * 136 + 32 * ks + 8 * fg);
                const bf16x8 b = *(const LAS bf16x8*)(KB + (16 * jt + fr) * 136 + 32 * ks + 8 * fg);
                acc = MFMA16(a, b, acc);
            }
            const int j = 16 * jt + fr; const float cj = SM[j];
#pragma unroll
            for (int r = 0; r < 4; ++r) { const int i = 16 * it + 4 * fg + r;
                AM[i * 68 + j] = (i > j) ? SM[128 + i] * expf(SM[i] - cj) * acc[r] : 0.f; }
        }
    }
    __syncthreads();
    float sol[64];
    if (wave < 4) {
        const int c = tid;
        unsigned srcb = (unsigned)(uintptr_t)((wave < 2) ? (VF + c) : (KF + (c - 128)));
        unsigned sclb = (unsigned)(uintptr_t)(SM + ((wave < 2) ? 128 : 256));
        unsigned amb = (unsigned)(uintptr_t)AM;
        asm volatile("" : "+v"(srcb), "+v"(sclb), "+v"(amb));
#pragma unroll
        for (int i = 0; i < 64; ++i) sol[i] = 0.f;
#pragma unroll
        for (int i = 0; i < 64; ++i) {
            const float rhs = *(const LAS float*)(srcb + i * 528) * *(const LAS float*)(sclb + i * 4);
            f32x4 pa = {0.f, 0.f, 0.f, 0.f};
#pragma unroll
            for (int j4 = 0; j4 < i; j4 += 4) { const f32x4 a = *(const LAS f32x4*)(amb + (i * 68 + j4) * 4);
                pa.x += a.x * sol[j4];
                if (j4 + 1 < i) pa.y += a.y * sol[j4 + 1];
                if (j4 + 2 < i) pa.z += a.z * sol[j4 + 2];
                if (j4 + 3 < i) pa.w += a.w * sol[j4 + 3]; }
            sol[i] = rhs - ((pa.x + pa.y) + (pa.z + pa.w));
            asm volatile("" : "+v"(sol[i]) :: "memory");
        }
        if (wave < 2) {
            float* ub = (float*)(ops + DN_UB);
            const int w = c >> 4;
#pragma unroll
            for (int mt = 0; mt < 4; ++mt)
#pragma unroll
                for (int g = 0; g < 4; ++g)
                    *(GAS f32x4*)(ub + (((w * 4 + mt) * 64 + 16 * g + (c & 15)) * 4)) = (f32x4){sol[16 * mt + 4 * g], sol[16 * mt + 4 * g + 1], sol[16 * mt + 4 * g + 2], sol[16 * mt + 4 * g + 3]};
        }
    } else {
        const int w4 = wave - 4;
        {
            const int mt = w4; f32x4 dq[4];
#pragma unroll
            for (int jt = 0; jt < 4; ++jt) { dq[jt] = (f32x4){0.f, 0.f, 0.f, 0.f};
                if (jt <= mt) {
#pragma unroll
                    for (int ks = 0; ks < 4; ++ks) {
                        const bf16x8 a = *(const LAS bf16x8*)(KB + (16 * jt + fr) * 136 + 32 * ks + 8 * fg);
                        const bf16x8 b = *(const LAS bf16x8*)(QB + (16 * mt + fr) * 136 + 32 * ks + 8 * fg);
                        dq[jt] = MFMA16(a, b, dq[jt]);
                    }
                    const int i = 16 * mt + fr; const float ci = SM[i];
#pragma unroll
                    for (int r = 0; r < 4; ++r) { const int j = 16 * jt + 4 * fg + r; dq[jt][r] = (j <= i) ? dq[jt][r] * expf(ci - SM[j]) : 0.f; }
                } }
#pragma unroll
            for (int sp = 0; sp < 2; ++sp) *(GAS bf16x8*)(ops + DN_QKF + ((mt * 2 + sp) * 64 + lane) * 16) = pack8(dq[2 * sp], dq[2 * sp + 1]);
        }
        {
            const int mt = w4, i = 16 * mt + fr; const float ec = SM[64 + i];
#pragma unroll
            for (int s = 0; s < 4; ++s) {
                const v2u a = *(const LAS v2u*)(QB + i * 136 + 32 * s + 4 * fg), b = *(const LAS v2u*)(QB + i * 136 + 32 * s + 16 + 4 * fg);
                v4u o; o.x = pkbf(bflo(a.x) * ec, bfhi(a.x) * ec); o.y = pkbf(bflo(a.y) * ec, bfhi(a.y) * ec); o.z = pkbf(bflo(b.x) * ec, bfhi(b.x) * ec); o.w = pkbf(bflo(b.y) * ec, bfhi(b.y) * ec);
                *(GAS v4u*)(ops + DN_QDF + ((mt * 4 + s) * 64 + lane) * 16) = o;
            }
        }
#pragma unroll
        for (int q = 0; q < 2; ++q) { const int mt = 2 * w4 + q, dk = 16 * mt + fr;
#pragma unroll
            for (int sp = 0; sp < 2; ++sp) { float v[8];
#pragma unroll
                for (int jj = 0; jj < 8; ++jj) { const int j = 32 * sp + 16 * (jj >> 2) + 4 * fg + (jj & 3); v[jj] = KF[j * 132 + dk] * SM[192 + j]; }
                v4u o; o.x = pkbf(v[0], v[1]); o.y = pkbf(v[2], v[3]); o.z = pkbf(v[4], v[5]); o.w = pkbf(v[6], v[7]);
                *(GAS v4u*)(ops + DN_KDF + ((mt * 2 + sp) * 64 + lane) * 16) = o; } }
    }
    __syncthreads();
    if (wave == 2 || wave == 3) { LAS float* WL = VF + (tid - 128);
#pragma unroll
        for (int i = 0; i < 64; ++i) WL[i * 132] = sol[i]; }
    __syncthreads();
#pragma unroll
    for (int q = 0; q < 2; ++q) { const int f = wave * 2 + q, mt = f >> 2, s = f & 3, i = 16 * mt + fr;
        const f32x4 a = *(const LAS f32x4*)(VF + i * 132 + 32 * s + 4 * fg), b = *(const LAS f32x4*)(VF + i * 132 + 32 * s + 16 + 4 * fg);
        *(GAS bf16x8*)(ops + DN_WF + (f * 64 + lane) * 16) = pack8(a, b); }
    __syncthreads();
}

__device__ __forceinline__ void dn_scan_unit(int h, int w, const unsigned char* dnops_all, const float* CD, float* ODN, LAS unsigned char* lds, int tid, int lane, int wave) {
    const unsigned char* base = dnops_all + (size_t)(h * 256) * DNOPS_BYTES;
    const int fr = lane & 15, fg = lane >> 4;
    for (int idx = tid; idx < 3584; idx += NTHR) *(LAS v4u*)(lds + idx * 16) = *(const GAS v4u*)(base + idx * 16);
    __syncthreads();
    f32x4 S[8];
#pragma unroll
    for (int i = 0; i < 8; ++i) S[i] = (f32x4){0.f, 0.f, 0.f, 0.f};
    f32x4 ubn[4];
    if (wave == 0) {
#pragma unroll
        for (int mt = 0; mt < 4; ++mt) ubn[mt] = *(const GAS f32x4*)(base + DN_UB + ((w * 4 + mt) * 64 + lane) * 16);
    }
    for (int n = 0; n < 256; ++n) {
        LAS unsigned char* cur = lds + (n & 1) * 57344;
        if (wave == 0) {
            const float cd = CD[h * 256 + n];
            f32x4 U[4];
#pragma unroll
            for (int mt = 0; mt < 4; ++mt) U[mt] = ubn[mt];
            if (n + 1 < 256) {
#pragma unroll
                for (int mt = 0; mt < 4; ++mt) ubn[mt] = *(const GAS f32x4*)(base + (size_t)(n + 1) * DNOPS_BYTES + DN_UB + ((w * 4 + mt) * 64 + lane) * 16);
            }
            bf16x8 Sb[4];
#pragma unroll
            for (int s = 0; s < 4; ++s) Sb[s] = pack8(S[2 * s], S[2 * s + 1]);
#pragma unroll
            for (int mt = 0; mt < 4; ++mt) { f32x4 acc = {0.f, 0.f, 0.f, 0.f};
#pragma unroll
                for (int s = 0; s < 4; ++s) acc = MFMA16(*(const LAS bf16x8*)(cur + DN_WF + ((mt * 4 + s) * 64 + lane) * 16), Sb[s], acc);
                U[mt] = U[mt] - acc; }
            bf16x8 Ub[2]; Ub[0] = pack8(U[0], U[1]); Ub[1] = pack8(U[2], U[3]);
#pragma unroll
            for (int mt = 0; mt < 4; ++mt) { f32x4 acc = {0.f, 0.f, 0.f, 0.f};
#pragma unroll
                for (int s = 0; s < 4; ++s) acc = MFMA16(*(const LAS bf16x8*)(cur + DN_QDF + ((mt * 4 + s) * 64 + lane) * 16), Sb[s], acc);
#pragma unroll
                for (int sp = 0; sp < 2; ++sp) acc = MFMA16(*(const LAS bf16x8*)(cur + DN_QKF + ((mt * 2 + sp) * 64 + lane) * 16), Ub[sp], acc);
                float* op = ODN + (size_t)(64 * n + 16 * mt + 4 * fg) * 512 + h * 128 + 16 * w + fr;
                op[0] = acc[0]; op[512] = acc[1]; op[1024] = acc[2]; op[1536] = acc[3]; }
#pragma unroll
            for (int mt = 0; mt < 8; ++mt) { f32x4 acc = S[mt] * cd;
#pragma unroll
                for (int sp = 0; sp < 2; ++sp) acc = MFMA16(*(const LAS bf16x8*)(cur + DN_KDF + ((mt * 2 + sp) * 64 + lane) * 16), Ub[sp], acc);
                S[mt] = acc; }
        } else if (n + 1 < 256) {
            const unsigned char* src = base + (size_t)(n + 1) * DNOPS_BYTES; LAS unsigned char* dst = lds + ((n + 1) & 1) * 57344;
            const int lt = tid - 64;
            v4u t[8];
#pragma unroll
            for (int i = 0; i < 8; ++i) t[i] = *(const GAS v4u*)(src + (lt + 448 * i) * 16);
#pragma unroll
            for (int i = 0; i < 8; ++i) *(LAS v4u*)(dst + (lt + 448 * i) * 16) = t[i];
        }
        __syncthreads();
    }
}

__device__ __forceinline__ float sum16(float v) { v += __shfl_xor(v, 1); v += __shfl_xor(v, 2); v += __shfl_xor(v, 4); v += __shfl_xor(v, 8); return v; }
template <bool DN>
__device__ __forceinline__ void p5a_norms(const float* ODN, const bf16* OA, const bf16* PJ, const float* dn_norm_w, const float* da_norm_w,
                                          const float* lq1, const float* lk1, const float* lq2, const float* lk2, bf16* A5, int lane, int wave) {
    const float lam = expf(wave_sum(lq1[lane] * lk1[lane])) - expf(wave_sum(lq2[lane] * lk2[lane])) + LAM_INIT;
    const int hd = lane >> 4, d0 = (lane & 15) * 8;
    float wn[8], wa[8];
#pragma unroll
    for (int e = 0; e < 8; ++e) { wn[e] = dn_norm_w[d0 + e]; wa[e] = da_norm_w[d0 + e] * (1.0f - LAM_INIT); }
    const int half = d0 >> 6, dd = d0 & 63;
    const int gw = blockIdx.x * NWAVES + wave, NGW = gridDim.x * NWAVES;
    for (int m = gw; m < M; m += NGW) {
        const f32x4 a = *(const GAS f32x4*)(ODN + (size_t)m * 512 + hd * 128 + d0), b = *(const GAS f32x4*)(ODN + (size_t)m * 512 + hd * 128 + d0 + 4);
        const v4u zr = *(const GAS v4u*)(PJ + (size_t)m * NPJ + PJ_Z + hd * 128 + d0);
        float o[8] = {a.x, a.y, a.z, a.w, b.x, b.y, b.z, b.w};
        float ss = 0.f;
#pragma unroll
        for (int e = 0; e < 8; ++e) ss += o[e] * o[e];
        ss = sum16(ss);
        const float rn = rsqrtf(ss * (1.0f / 128.0f) + 1e-5f);
        const float z[8] = {bflo(zr.x), bfhi(zr.x), bflo(zr.y), bfhi(zr.y), bflo(zr.z), bfhi(zr.z), bflo(zr.w), bfhi(zr.w)};
#pragma unroll
        for (int e = 0; e < 8; ++e) o[e] = o[e] * rn * wn[e] * (z[e] / (1.f + __expf(-z[e])));
        v4u pk; pk.x = pkbf(o[0], o[1]); pk.y = pkbf(o[2], o[3]); pk.z = pkbf(o[4], o[5]); pk.w = pkbf(o[6], o[7]);
        if (!DN) pk = (v4u){0u, 0u, 0u, 0u};
        *(GAS v4u*)(A5 + (size_t)m * 1024 + hd * 128 + d0) = pk;
        const v4u p0 = *(const GAS v4u*)(OA + (size_t)m * 1024 + (hd * 4 + half) * 64 + dd), p1 = *(const GAS v4u*)(OA + (size_t)m * 1024 + (hd * 4 + 2 + half) * 64 + dd);
        float q[8] = {bflo(p0.x) - lam * bflo(p1.x), bfhi(p0.x) - lam * bfhi(p1.x), bflo(p0.y) - lam * bflo(p1.y), bfhi(p0.y) - lam * bfhi(p1.y),
                      bflo(p0.z) - lam * bflo(p1.z), bfhi(p0.z) - lam * bfhi(p1.z), bflo(p0.w) - lam * bflo(p1.w), bfhi(p0.w) - lam * bfhi(p1.w)};
        float s2 = 0.f;
#pragma unroll
        for (int e = 0; e < 8; ++e) s2 += q[e] * q[e];
        s2 = sum16(s2);
        const float rn2 = rsqrtf(s2 * (1.0f / 128.0f) + 1e-5f);
#pragma unroll
        for (int e = 0; e < 8; ++e) q[e] = q[e] * rn2 * wa[e];
        v4u pq; pq.x = pkbf(q[0], q[1]); pq.y = pkbf(q[2], q[3]); pq.z = pkbf(q[4], q[5]); pq.w = pkbf(q[6], q[7]);
        *(GAS v4u*)(A5 + (size_t)m * 1024 + 512 + hd * 128 + d0) = pq;
    }
}

namespace pg8 {
#define EPI_WALK(...) \
    _Pragma("unroll") for (int ai = 0; ai < 2; ++ai) _Pragma("unroll") for (int m = 0; m < 4; ++m) { const int row = u.pm * BM + ai * HALF + wr * 64 + m * 16 + fr; \
        _Pragma("unroll") for (int bj = 0; bj < 2; ++bj) { const int col = u.pn * BM + bj * HALF + wc * 32 + 8 * fq; const f32x4 v0 = acc[ai][bj][m][0], v1 = acc[ai][bj][m][1]; __VA_ARGS__ } }
__device__ __forceinline__ void unpack8(const u32x4 g, float (&o)[8]) { o[0] = bflo(g.x); o[1] = bfhi(g.x); o[2] = bflo(g.y); o[3] = bfhi(g.y); o[4] = bflo(g.z); o[5] = bfhi(g.z); o[6] = bflo(g.w); o[7] = bfhi(g.w); }
struct EpiGateF32 { static constexpr bool PERM = true, AFTER_DRAIN = false; const bf16_t* PJg; float* T;
    __device__ __forceinline__ void operator()(const f32x4 (&acc)[2][2][4][2], const Unit& u, int wr, int wc, int fr, int fq) const {
        EPI_WALK({ float g[8]; unpack8(*(const u32x4*)(PJg + (size_t)row * NPJ + col), g);
            f32x4 o0, o1; o0.x = v0.x * sigmoidf_(g[0]); o0.y = v0.y * sigmoidf_(g[1]); o0.z = v0.z * sigmoidf_(g[2]); o0.w = v0.w * sigmoidf_(g[3]);
            o1.x = v1.x * sigmoidf_(g[4]); o1.y = v1.y * sigmoidf_(g[5]); o1.z = v1.z * sigmoidf_(g[6]); o1.w = v1.w * sigmoidf_(g[7]);
            float* tp = T + (size_t)row * 1024 + col; *(f32x4*)tp = o0; *(f32x4*)(tp + 4) = o1; })
    } };
struct EpiGateAdd { static constexpr bool PERM = true, AFTER_DRAIN = false; const bf16_t* PJg; const float* T; bf16_t* MG;
    __device__ __forceinline__ void operator()(const f32x4 (&acc)[2][2][4][2], const Unit& u, int wr, int wc, int fr, int fq) const {
        EPI_WALK({ float g[8]; unpack8(*(const u32x4*)(PJg + (size_t)row * NPJ + col), g);
            const float* tp = T + (size_t)row * 1024 + col; const f32x4 t0 = *(const f32x4*)tp, t1 = *(const f32x4*)(tp + 4);
            u32x4 w; w.x = pkbf(t0.x + v0.x * sigmoidf_(g[0]), t0.y + v0.y * sigmoidf_(g[1])); w.y = pkbf(t0.z + v0.z * sigmoidf_(g[2]), t0.w + v0.w * sigmoidf_(g[3]));
            w.z = pkbf(t1.x + v1.x * sigmoidf_(g[4]), t1.y + v1.y * sigmoidf_(g[5])); w.w = pkbf(t1.z + v1.z * sigmoidf_(g[6]), t1.w + v1.w * sigmoidf_(g[7]));
            *(u32x4*)(MG + (size_t)row * 1024 + col) = w; })
    } };
struct EpiResid { static constexpr bool PERM = true, AFTER_DRAIN = false; const float* x; const float* modsp; const float* b_ada; float* Z;
    __device__ __forceinline__ void operator()(const f32x4 (&acc)[2][2][4][2], const Unit& u, int wr, int wc, int fr, int fq) const {
        f32x4 gm[2][2];
#pragma unroll
        for (int bj = 0; bj < 2; ++bj) { const int c = u.pn * BM + bj * HALF + wc * 32 + 8 * fq; gm[bj][0] = mods4(modsp, b_ada, 2048 + c); gm[bj][1] = mods4(modsp, b_ada, 2048 + c + 4); }
        EPI_WALK({ const float* xp = x + (size_t)row * 1024 + col; const f32x4 x0 = *(const f32x4*)xp, x1 = *(const f32x4*)(xp + 4);
            float* zp = Z + (size_t)row * 1024 + col; *(f32x4*)zp = x0 * DN_ALPHA + gm[bj][0] * v0; *(f32x4*)(zp + 4) = x1 * DN_ALPHA + gm[bj][1] * v1; })
    } };
__device__ __forceinline__ float swiglu1(float g, float l) { g = fminf(g, 7.0f); l = fminf(fmaxf(l, -7.0f), 7.0f); return g * (1.f / (1.f + __expf(-1.702f * g))) * (l + 1.0f); }
struct EpiSwiglu { static constexpr bool PERM = true, AFTER_DRAIN = false; const float* bias; bf16_t* ACT;
    __device__ __forceinline__ void operator()(const f32x4 (&acc)[2][2][4][2], const Unit& u, int wr, int wc, int fr, int fq) const {
        const float* bp = bias + (size_t)u.e * 2048;
        f32x4 bv[2][2];
#pragma unroll
        for (int bj = 0; bj < 2; ++bj) { const int c = u.pn * BM + bj * HALF + wc * 32 + 8 * fq; bv[bj][0] = *(const f32x4*)(bp + c); bv[bj][1] = *(const f32x4*)(bp + c + 4); }
        EPI_WALK({ const f32x4 a = v0 + bv[bj][0], b = v1 + bv[bj][1];
            v2u w; w.x = pkbf(swiglu1(a.x, a.y), swiglu1(a.z, a.w)); w.y = pkbf(swiglu1(b.x, b.y), swiglu1(b.z, b.w));
            *(v2u*)(ACT + (size_t)row * 1024 + (col >> 1)) = w; })
    } };
struct EpiDown { static constexpr bool PERM = true, AFTER_DRAIN = false; const float* bias; const float* roww; bf16_t* EO;
    __device__ __forceinline__ void operator()(const f32x4 (&acc)[2][2][4][2], const Unit& u, int wr, int wc, int fr, int fq) const {
        const float* bp = bias + (size_t)u.e * 1024;
        f32x4 bv[2][2];
#pragma unroll
        for (int bj = 0; bj < 2; ++bj) { const int c = u.pn * BM + bj * HALF + wc * 32 + 8 * fq; bv[bj][0] = *(const f32x4*)(bp + c); bv[bj][1] = *(const f32x4*)(bp + c + 4); }
        EPI_WALK({ const float rw = roww[row]; const f32x4 a = (v0 + bv[bj][0]) * rw, b = (v1 + bv[bj][1]) * rw;
            u32x4 w; w.x = pkbf(a.x, a.y); w.y = pkbf(a.z, a.w); w.z = pkbf(b.x, b.y); w.w = pkbf(b.z, b.w);
            *(u32x4*)(EO + (size_t)row * 1024 + col) = w; })
    } };
struct MoeOrder {
    const int* blk_e; int nblk, nN, G, c;
    __device__ __forceinline__ bool next(int i, Unit& u) const { const int L = i * G + c; if (L >= nblk * nN) return false; u.pm = L / nN; u.pn = L % nN; u.e = blk_e[u.pm]; return true; }
    __device__ __forceinline__ void a_ready(const Unit&) const {}
    __device__ __forceinline__ void done(const Unit&) const {}
};
}

constexpr int P6_WR_PITCH = 1028, P6_SCR = 131584;
template <bool ZFROMX>
__device__ __forceinline__ void p6_ln1_route(const float* Zsrc, const float* ln_g, const float* ln_b, const float* modsp, const float* b_ada, const float* w_router, const float* b_router,
                                             unsigned char* ws, LAS unsigned char* lds, int tid, int lane, int wave) {
    LAS float* WR = (LAS float*)lds; LAS int* te = (LAS int*)(lds + P6_SCR);
    for (int idx = tid; idx < 32768; idx += NTHR) { const int k = idx >> 5, e = idx & 31; WR[e * P6_WR_PITCH + k] = w_router[idx]; }
    f32x4 lg[4], lb[4], sc[4], sh[4];
#pragma unroll
    for (int j = 0; j < 4; ++j) { const int c = 256 * j + 4 * lane; lg[j] = *(const f32x4*)(ln_g + c); lb[j] = *(const f32x4*)(ln_b + c);
        sh[j] = mods4(modsp, b_ada, 3072 + c); sc[j] = mods4(modsp, b_ada, 4096 + c) + 1.0f; }
    const int eidx = ((lane >> 5) & 1) * 16 + ((lane >> 4) & 1) * 8 + ((lane >> 3) & 1) * 4 + ((lane >> 2) & 1) * 2 + ((lane >> 1) & 1);
    const float brt = b_router[eidx];
    __syncthreads();
    float* X1 = (float*)(ws + WS_X1); bf16* H = (bf16*)(ws + WS_H); int* TOKE = (int*)(ws + WS_TOKE); float* TOKW = (float*)(ws + WS_TOKW);
    for (int rr = 0; rr < 8; ++rr) {
        const int rl = wave * 8 + rr, m = blockIdx.x * 64 + rl;
        const GAS f32x4* zr = (const GAS f32x4*)(Zsrc + (size_t)m * D) + lane;
        f32x4 v[4]; float s = 0.f;
#pragma unroll
        for (int j = 0; j < 4; ++j) { v[j] = zr[64 * j]; if (ZFROMX) v[j] = v[j] * DN_ALPHA; s += (v[j].x + v[j].y) + (v[j].z + v[j].w); }
        const float mean = wave_sum(s) * (1.f / D); float s2 = 0.f;
#pragma unroll
        for (int j = 0; j < 4; ++j) { v[j] = v[j] - mean; s2 += (v[j].x * v[j].x + v[j].y * v[j].y) + (v[j].z * v[j].z + v[j].w * v[j].w); }
        const float rstd = rsqrtf(wave_sum(s2) * (1.f / D) + LN_EPS);
        GAS f32x4* xo = (GAS f32x4*)(X1 + (size_t)m * D) + lane;
        GAS unsigned long long* ho = (GAS unsigned long long*)(H + (size_t)m * D) + lane;
        f32x4 hv[4];
#pragma unroll
        for (int j = 0; j < 4; ++j) { const f32x4 x1 = v[j] * rstd * lg[j] + lb[j]; xo[64 * j] = x1; hv[j] = x1 * sc[j] + sh[j];
            ho[64 * j] = (unsigned long long)pkbf(hv[j].x, hv[j].y) | ((unsigned long long)pkbf(hv[j].z, hv[j].w) << 32); }
        float p[32];
#pragma unroll
        for (int e = 0; e < 32; ++e) { float a = 0.f;
#pragma unroll
            for (int j = 0; j < 4; ++j) { const f32x4 w = *(const LAS f32x4*)(WR + e * P6_WR_PITCH + 256 * j + 4 * lane); a += (hv[j].x * w.x + hv[j].y * w.y) + (hv[j].z * w.z + hv[j].w * w.w); }
            p[e] = a; }
        float r16[16], r8[8], r4[4], r2[2];
        { const bool up = (lane & 32) != 0;
#pragma unroll
          for (int e = 0; e < 16; ++e) { const float keep = up ? p[e + 16] : p[e], send = up ? p[e] : p[e + 16]; r16[e] = keep + __shfl_xor(send, 32); } }
        { const bool up = (lane & 16) != 0;
#pragma unroll
          for (int e = 0; e < 8; ++e) { const float keep = up ? r16[e + 8] : r16[e], send = up ? r16[e] : r16[e + 8]; r8[e] = keep + __shfl_xor(send, 16); } }
        { const bool up = (lane & 8) != 0;
#pragma unroll
          for (int e = 0; e < 4; ++e) { const float keep = up ? r8[e + 4] : r8[e], send = up ? r8[e] : r8[e + 4]; r4[e] = keep + __shfl_xor(send, 8); } }
        { const bool up = (lane & 4) != 0;
#pragma unroll
          for (int e = 0; e < 2; ++e) { const float keep = up ? r4[e + 2] : r4[e], send = up ? r4[e] : r4[e + 2]; r2[e] = keep + __shfl_xor(send, 4); } }
        float lgt;
        { const bool up = (lane & 2) != 0; const float keep = up ? r2[1] : r2[0], send = up ? r2[0] : r2[1]; lgt = keep + __shfl_xor(send, 2); }
        lgt += __shfl_xor(lgt, 1);
        lgt += brt;
        float tv[4]; int ti[4];
#pragma unroll
        for (int k = 0; k < 4; ++k) {
            float bv = lgt; int bi = eidx;
#pragma unroll
            for (int o = 1; o < 64; o <<= 1) { const float ov = __shfl_xor(bv, o); const int oi = __shfl_xor(bi, o); if (ov > bv || (ov == bv && oi < bi)) { bv = ov; bi = oi; } }
            tv[k] = bv; ti[k] = bi; if (eidx == bi) lgt = -INFINITY;
        }
        const float e1 = expf(tv[1] - tv[0]), e2 = expf(tv[2] - tv[0]), e3 = expf(tv[3] - tv[0]), inv = 1.f / (1.f + e1 + e2 + e3);
        if (lane == 0) {
            *(v4i*)(TOKE + (size_t)m * 4) = (v4i){ti[0], ti[1], ti[2], ti[3]};
            *(f32x4*)(TOKW + (size_t)m * 4) = (f32x4){inv, e1 * inv, e2 * inv, e3 * inv};
            te[rl * 4 + 0] = ti[0]; te[rl * 4 + 1] = ti[1]; te[rl * 4 + 2] = ti[2]; te[rl * 4 + 3] = ti[3];
        }
    }
    __syncthreads();
    int* TOKR = (int*)(ws + WS_TOKR); int* CNT = (int*)(ws + WS_CNT);
    if (tid < 256) { const int e = te[tid]; int r = 0; for (int a = 0; a < tid; ++a) r += (te[a] == e) ? 1 : 0; TOKR[(size_t)blockIdx.x * 256 + tid] = r; }
    else if (tid < 288) { const int e = tid - 256; int c = 0; for (int a = 0; a < 256; ++a) c += (te[a] == e) ? 1 : 0; CNT[blockIdx.x * 32 + e] = c; }
    __syncthreads();
}

__device__ __forceinline__ void p7_scatter(unsigned char* ws, LAS unsigned char* lds, int tid, int lane, int wave) {
    LAS int* tot = (LAS int*)lds; LAS int* mine = tot + 32; LAS int* pst = tot + 64; LAS int* posl = tot + 128;
    const int* CNT = (const int*)(ws + WS_CNT); const int b = blockIdx.x;
    if (tid < 32) { int t = 0, mi = 0; for (int bb = 0; bb < 256; ++bb) { const int c = CNT[bb * 32 + tid]; t += c; mi += (bb < b) ? c : 0; } tot[tid] = t; mine[tid] = mi; }
    __syncthreads();
    if (tid == 0) { int acc = 0; int* BLKE = (int*)(ws + WS_BLKE);
        for (int e = 0; e < 32; ++e) { pst[e] = acc * 256; const int nb = (tot[e] + 255) >> 8; if (b == 0) for (int q = 0; q < nb; ++q) BLKE[acc + q] = e; acc += nb; }
        if (b == 0) BLKE[MOE_MAXBLK] = acc; }
    __syncthreads();
    const int* TOKE = (const int*)(ws + WS_TOKE); const float* TOKW = (const float*)(ws + WS_TOKW); const int* TOKR = (const int*)(ws + WS_TOKR);
    int* TOKP = (int*)(ws + WS_TOKP); float* ROWW = (float*)(ws + WS_ROWW);
    if (tid < 256) { const size_t a = (size_t)b * 256 + tid; const int e = TOKE[a]; const int pos = pst[e] + mine[e] + TOKR[a]; TOKP[a] = pos; ROWW[pos] = TOKW[a]; posl[tid] = pos; }
    __syncthreads();
    const bf16* H = (const bf16*)(ws + WS_H); bf16* HS = (bf16*)(ws + WS_HS);
    for (int a = wave; a < 256; a += NWAVES) { const int m = b * 64 + (a >> 2), pos = posl[a];
        const GAS v4u* src = (const GAS v4u*)(H + (size_t)m * D) + lane; GAS v4u* dst = (GAS v4u*)(HS + (size_t)pos * D) + lane;
        const v4u x0 = src[0], x1 = src[64]; dst[0] = x0; dst[64] = x1; }
    __syncthreads();
}

template <bool NOFFN>
__device__ __forceinline__ void p10_combine_ln2(const float* ln_g, const float* ln_b, const float* modsp, const float* b_ada, unsigned char* ws, float* out, int lane, int wave) {
    const float* X1 = (const float*)(ws + WS_X1); const bf16* EO = (const bf16*)(ws + WS_EO); const int* TOKP = (const int*)(ws + WS_TOKP);
    f32x4 lg[4], lb[4], gf[4];
#pragma unroll
    for (int j = 0; j < 4; ++j) { const int c = 256 * j + 4 * lane; lg[j] = *(const f32x4*)(ln_g + c); lb[j] = *(const f32x4*)(ln_b + c); gf[j] = mods4(modsp, b_ada, 5120 + c); }
    const int gw = blockIdx.x * NWAVES + wave, NGW = gridDim.x * NWAVES;
    for (int m = gw; m < M; m += NGW) {
        const GAS f32x4* xr = (const GAS f32x4*)(X1 + (size_t)m * D) + lane;
        f32x4 v[4];
#pragma unroll
        for (int j = 0; j < 4; ++j) v[j] = xr[64 * j] * DN_ALPHA;
        if (!NOFFN) {
            const v4i pp = *(const v4i*)(TOKP + (size_t)m * 4);
            const int ps[4] = {pp.x, pp.y, pp.z, pp.w};
            f32x4 y[4];
#pragma unroll
            for (int j = 0; j < 4; ++j) y[j] = (f32x4){0.f, 0.f, 0.f, 0.f};
#pragma unroll
            for (int k = 0; k < 4; ++k) { const GAS v2u* er = (const GAS v2u*)(EO + (size_t)ps[k] * D) + lane;
#pragma unroll
                for (int j = 0; j < 4; ++j) { const v2u q = er[64 * j]; y[j].x += bflo(q.x); y[j].y += bfhi(q.x); y[j].z += bflo(q.y); y[j].w += bfhi(q.y); } }
#pragma unroll
            for (int j = 0; j < 4; ++j) v[j] = v[j] + gf[j] * y[j];
        }
        float s = 0.f;
#pragma unroll
        for (int j = 0; j < 4; ++j) s += (v[j].x + v[j].y) + (v[j].z + v[j].w);
        const float mean = wave_sum(s) * (1.f / D); float s2 = 0.f;
#pragma unroll
        for (int j = 0; j < 4; ++j) { v[j] = v[j] - mean; s2 += (v[j].x * v[j].x + v[j].y * v[j].y) + (v[j].z * v[j].z + v[j].w * v[j].w); }
        const float rstd = rsqrtf(wave_sum(s2) * (1.f / D) + LN_EPS);
        GAS f32x4* o = (GAS f32x4*)(out + (size_t)m * D) + lane;
#pragma unroll
        for (int j = 0; j < 4; ++j) o[64 * j] = v[j] * rstd * lg[j] + lb[j];
    }
}

#ifndef STAGE
#define STAGE 4
#endif
struct Args { const void* in[28]; float* out; unsigned char* ws; };
__device__ __forceinline__ int q_pop(gu32* ctr, volatile LAS unsigned* slot, int tid) {
    if (tid == 0) *slot = __hip_atomic_fetch_add(ctr, 1u, RLX_AGENT);
    __syncthreads(); const int v = (int)*slot; __syncthreads(); return v;
}
#define FRESH() int tid = threadIdx.x; asm volatile("" : "+v"(tid)); const int lane = tid & 63, wave = __builtin_amdgcn_readfirstlane(tid >> 6); (void)lane; (void)wave
__global__ void __launch_bounds__(NTHR, 2) fwd(Args args) {
    extern __shared__ __attribute__((aligned(16))) unsigned char lds_raw[];
    LAS unsigned char* lds = (LAS unsigned char*)lds_raw;
    const int G = gridDim.x;
    unsigned char* ws = args.ws;
    gu32* ctl = (gu32*)(ws + WS_CTL);
    for (int u = threadIdx.x; u < (LDS_BYTES - LDSCTL_OFF) / 4; u += NTHR) ((LAS unsigned*)(lds + LDSCTL_OFF))[u] = 0u;
    __syncthreads();
    volatile LAS unsigned* lctl = (volatile LAS unsigned*)(lds + LDSCTL_OFF);
    XcdBarrier bar = xcd_barrier_post((unsigned*)(ws + WS_CTL) + CW_BAR, lctl);

    const float* x = (const float*)args.in[0]; const float* cvec = (const float*)args.in[1]; const int* positions = (const int*)args.in[2];
    const float* w_ada = (const float*)args.in[3]; const float* b_ada = (const float*)args.in[4]; const float* w_in = (const float*)args.in[5];
    const float* conv_w = (const float*)args.in[6]; const float* a_log = (const float*)args.in[7]; const float* dt_bias = (const float*)args.in[8];
    const float* dn_norm_w = (const float*)args.in[9]; const float* w_dn = (const float*)args.in[10];
    const float* lq1 = (const float*)args.in[11]; const float* lk1 = (const float*)args.in[12]; const float* lq2 = (const float*)args.in[13]; const float* lk2 = (const float*)args.in[14];
    const float* da_norm_w = (const float*)args.in[15]; const float* w_da = (const float*)args.in[16]; const float* w_o = (const float*)args.in[17];
    const float* ln1_g = (const float*)args.in[18]; const float* ln1_b = (const float*)args.in[19]; const float* w_router = (const float*)args.in[20]; const float* b_router = (const float*)args.in[21];
    const float* w_gu = (const float*)args.in[22]; const float* b_gu = (const float*)args.in[23]; const float* w_dw = (const float*)args.in[24]; const float* b_dw = (const float*)args.in[25];
    const float* ln2_g = (const float*)args.in[26]; const float* ln2_b = (const float*)args.in[27];
    float* modsp = (float*)(ws + WS_MODSP);
    bf16* PJ = (bf16*)(ws + WS_PJ);

    { FRESH();
    p0_mods(cvec, w_ada, modsp, (LAS float*)lds, lane, wave);
    p0_weights<(STAGE >= 2)>(w_in, w_dn, w_da, w_o, w_gu, w_dw, ws, lds, lane, wave); }
    xcd_barrier(bar);

#if STAGE >= 3
    { FRESH(); p1_modulate(x, w_in, modsp, b_ada, a_log, dt_bias, ws, lds, tid, lane, wave); }
    xcd_barrier(bar);
    {
        pg8::Gemm g{(const bf16*)(ws + WS_U), (const bf16*)(ws + WS_WINT), M, NPJ, 1024, 1024, 1024, 0};
        pg8::StaticOrder S; S.init(M, NPJ, G, (int)blockIdx.x);
        pg8::EpiBf16<0> E{PJ, NPJ, nullptr, 0, 0, 1.f};
        pg8::gemm_phase<pg8::EpiBf16<0>, pg8::StaticOrder, true, true>(lds, g, S, E);
    }
    xcd_barrier(bar);
    for (int u = (int)blockIdx.x; u < 1280; u += G) { FRESH();
        if (u < 1024) {
#if STAGE >= 4
            dn_prep_unit(u & 255, u >> 8, PJ, conv_w, (const float*)(ws + WS_G), (const float*)(ws + WS_BETA), (float*)(ws + WS_CD), ws + WS_DNOPS, lds, tid, lane, wave);
#endif
        } else p3_rope_unit(u - 1024, positions, PJ, (bf16*)(ws + WS_QR), (bf16*)(ws + WS_KR), tid);
    }
    xcd_barrier(bar);
#if STAGE >= 4
    for (;;) { FRESH(); const int idx = q_pop(ctl + CW_SCANQ, lctl + 4, tid); if (idx >= 32) break;
        dn_scan_unit(idx >> 3, idx & 7, ws + WS_DNOPS, (const float*)(ws + WS_CD), (float*)(ws + WS_ODN), lds, tid, lane, wave); }
#endif
    {
        const int xcc = (int)(xb_xcc_id() & 7u);
        for (int j = 0; j < 8; ++j) { const int q = (xcc + j) & 7;
            for (;;) { FRESH(); const int idx = q_pop(ctl + CW_ATTQ + 64 * q, lctl + 4, tid); if (idx >= 128) break;
                const int qb = 63 - (idx >> 1), vh = 2 * q + (idx & 1), hh = vh >> 2, mp = (vh >> 1) & 1, hf = vh & 1;
                attn_body::attn_unit<8>((hh * 2 + mp) * 64, hh * 128 + hf * 64, vh * 64, qb, (const attn_body::bf16*)(ws + WS_QR), (const attn_body::bf16*)(ws + WS_KR),
                                        (const attn_body::bf16*)(PJ + PJ_AV), (attn_body::bf16*)(ws + WS_OA), (char*)lds_raw); } }
    }
    xcd_barrier(bar);
    { FRESH(); p5a_norms<(STAGE >= 4)>((const float*)(ws + WS_ODN), (const bf16*)(ws + WS_OA), PJ, dn_norm_w, da_norm_w, lq1, lk1, lq2, lk2, (bf16*)(ws + WS_A5), lane, wave); }
    xcd_barrier(bar);
    {
        pg8::StaticOrder S; S.init(M, 1024, G, (int)blockIdx.x);
        pg8::Gemm g1{(const bf16*)(ws + WS_A5), (const bf16*)(ws + WS_WDNT), M, 1024, 512, 1024, 512, 0};
        pg8::EpiGateF32 E1{PJ + PJ_GDN, (float*)(ws + WS_T)};
        pg8::gemm_phase<pg8::EpiGateF32, pg8::StaticOrder, true, true>(lds, g1, S, E1);
        pg8::Gemm g2{(const bf16*)(ws + WS_A5) + 512, (const bf16*)(ws + WS_WDAT), M, 1024, 512, 1024, 512, 0};
        pg8::EpiGateAdd E2{PJ + PJ_GDA, (const float*)(ws + WS_T), (bf16*)(ws + WS_MG)};
        pg8::gemm_phase<pg8::EpiGateAdd, pg8::StaticOrder, true, true>(lds, g2, S, E2);
    }
    xcd_barrier(bar);
    {
        pg8::StaticOrder S; S.init(M, 1024, G, (int)blockIdx.x);
        pg8::Gemm g{(const bf16*)(ws + WS_MG), (const bf16*)(ws + WS_WOT), M, 1024, 1024, 1024, 1024, 0};
        pg8::EpiResid E{x, modsp, b_ada, (float*)(ws + WS_Z)};
        pg8::gemm_phase<pg8::EpiResid, pg8::StaticOrder, true, true>(lds, g, S, E);
    }
    xcd_barrier(bar);
    { FRESH(); p6_ln1_route<false>((const float*)(ws + WS_Z), ln1_g, ln1_b, modsp, b_ada, w_router, b_router, ws, lds, tid, lane, wave); }
#else
    { FRESH(); p6_ln1_route<true>(x, ln1_g, ln1_b, modsp, b_ada, w_router, b_router, ws, lds, tid, lane, wave); }
#endif
    xcd_barrier(bar);
#if STAGE >= 2
    { FRESH(); p7_scatter(ws, lds, tid, lane, wave); }
    xcd_barrier(bar);
    {
        const int* BLKE = (const int*)(ws + WS_BLKE); const int nblk = BLKE[MOE_MAXBLK];
        pg8::Gemm g{(const bf16*)(ws + WS_HS), (const bf16*)(ws + WS_WGUT), MOE_ROWS, 2048, 1024, 1024, 1024, (size_t)2048 * 1024 * 2};
        pg8::MoeOrder S{BLKE, nblk, 8, G, (int)blockIdx.x};
        pg8::EpiSwiglu E{b_gu, (bf16*)(ws + WS_ACT)};
        pg8::gemm_phase<pg8::EpiSwiglu, pg8::MoeOrder, true, true>(lds, g, S, E);
    }
    xcd_barrier(bar);
    {
        const int* BLKE = (const int*)(ws + WS_BLKE); const int nblk = BLKE[MOE_MAXBLK];
        pg8::Gemm g{(const bf16*)(ws + WS_ACT), (const bf16*)(ws + WS_WDT), MOE_ROWS, 1024, 1024, 1024, 1024, (size_t)1024 * 1024 * 2};
        pg8::MoeOrder S{BLKE, nblk, 4, G, (int)blockIdx.x};
        pg8::EpiDown E{b_dw, (const float*)(ws + WS_ROWW), (bf16*)(ws + WS_EO)};
        pg8::gemm_phase<pg8::EpiDown, pg8::MoeOrder, true, true>(lds, g, S, E);
    }
    xcd_barrier(bar);
    { FRESH(); p10_combine_ln2<false>(ln2_g, ln2_b, modsp, b_ada, ws, args.out, lane, wave); }
#else
    { FRESH(); p10_combine_ln2<true>(ln2_g, ln2_b, modsp, b_ada, ws, args.out, lane, wave); }
#endif
}

extern "C" void kernel_launch(void* const* d_in, const int* in_sizes, int n_in, void* d_out, int out_size, void* d_ws, size_t ws_size, hipStream_t stream) {
    static int grid = 0;
    if (grid == 0) {
        if (n_in != 28 || out_size != M * D || ws_size < WS_END) { fprintf(stderr, "kernel_launch: unexpected shapes (n_in %d, out %d, ws %zu)\n", n_in, out_size, ws_size); grid = -1; return; }
        int dev = 0, cus = 0, per_cu = 0;
        if (hipGetDevice(&dev) != hipSuccess || hipDeviceGetAttribute(&cus, hipDeviceAttributeMultiprocessorCount, dev) != hipSuccess) { grid = -1; return; }
        if (hipFuncSetAttribute((const void*)fwd, hipFuncAttributeMaxDynamicSharedMemorySize, LDS_BYTES) != hipSuccess) { fprintf(stderr, "kernel_launch: hipFuncSetAttribute failed\n"); grid = -1; return; }
        if (hipOccupancyMaxActiveBlocksPerMultiprocessor(&per_cu, (const void*)fwd, NTHR, LDS_BYTES) != hipSuccess || per_cu < 1)
            fprintf(stderr, "kernel_launch: occupancy query reports %d blocks per CU\n", per_cu);
        (void)hipGetLastError();
        grid = cus;
        if (grid > 256) grid = 256;
    }
    if (grid < 0) return;
    if (hipMemsetAsync((char*)d_ws + WS_CTL, 0, CTL_ZERO_BYTES, stream) != hipSuccess) return;
    Args a{};
    for (int i = 0; i < 28; ++i) a.in[i] = d_in[i];
    a.out = (float*)d_out; a.ws = (unsigned char*)d_ws;
    hipLaunchKernelGGL(fwd, dim3(grid), dim3(NTHR), LDS_BYTES, stream, a);
}
```
